# Optimizing an MI355X kernel written in HIP

```python
import math
import jax, jax.numpy as jnp
from jax import lax
import numpy as np

D_MODEL = 1024
BATCH = 16
SEQ = 2048
DEPTH = 2

CHUNK = 64
Q_BLOCK = 128
ROPE_THETA = 500000.0
NORM_EPS = 1e-6
ROPE_FRACTION_DEN = 4

DSA_HEADS = 4
DSA_HEAD_DIM = 64
DSA_IDX_HEADS = 8
DSA_IDX_DIM = 64
DSA_TOPK_MAX = 256
DSA_IDX_SCALE = (DSA_IDX_HEADS * DSA_IDX_DIM) ** -0.5

DIFF_HEADS = 4
DIFF_QK_DIM = 32
DIFF_V_DIM = 2 * DIFF_QK_DIM

MLA_HEADS = 8
MLA_Q_LORA = 256
MLA_KV_LORA = 128
MLA_NOPE_DIM = 64
MLA_ROPE_DIM = 32
MLA_V_DIM = 64

D_MIX = DSA_HEADS * DSA_HEAD_DIM + DIFF_HEADS * DIFF_V_DIM + MLA_HEADS * MLA_V_DIM

IN_SPLITS = (
    DSA_HEADS * DSA_HEAD_DIM,
    DSA_HEAD_DIM,
    DSA_HEAD_DIM,
    DSA_IDX_HEADS * DSA_IDX_DIM,
    DSA_IDX_DIM,
    DSA_IDX_HEADS,
    DIFF_HEADS * 2 * DIFF_QK_DIM,
    DIFF_HEADS * 2 * DIFF_QK_DIM,
    DIFF_HEADS * DIFF_V_DIM,
    MLA_Q_LORA,
    MLA_KV_LORA,
    MLA_ROPE_DIM,
)
N_IN = sum(IN_SPLITS)

D_FF = 3584
MOE_EXPERTS = 8
MOE_TOP_K = 2
MOE_D_FF = 3584
N_DENSE = (DEPTH + 1) // 2
N_MOE = DEPTH // 2

kernel_name = 'hybrid_dsa_diff_mla_moe_block'


def rms_norm(x, g):
    xf = x.astype(jnp.float32)
    y = xf * lax.rsqrt(jnp.mean(xf * xf, axis=-1, keepdims=True) + NORM_EPS)
    return (y * g.astype(jnp.float32)).astype(x.dtype)


def rope(x, pos, rot_dim):
    half = rot_dim // 2
    inv_freq = ROPE_THETA ** (-(jnp.arange(half, dtype=jnp.float32) * 2.0 / rot_dim))
    ang = pos.astype(jnp.float32)[..., None] * inv_freq
    ang = ang.reshape(ang.shape[:2] + (1,) * (x.ndim - 3) + (half,))
    cos, sin = jnp.cos(ang), jnp.sin(ang)
    xr = x[..., :rot_dim].astype(jnp.float32)
    x1, x2 = xr[..., :half], xr[..., half:]
    rot = jnp.concatenate([x1 * cos - x2 * sin, x2 * cos + x1 * sin], axis=-1).astype(x.dtype)
    return jnp.concatenate([rot, x[..., rot_dim:]], axis=-1)


def chunk_mask(blk, s_len):
    t = blk * Q_BLOCK + jnp.arange(Q_BLOCK)
    s = jnp.arange(s_len)
    return (s[None, :] // CHUNK) <= (t[:, None] // CHUNK)


def masked_softmax(logits, mask):
    return jax.nn.softmax(jnp.where(mask, logits.astype(jnp.float32), -jnp.inf), axis=-1)


def sweep_query_blocks(fn, *q_arrays):
    b, s = q_arrays[0].shape[:2]
    nb = s // Q_BLOCK
    xs = tuple(jnp.swapaxes(a.reshape((b, nb, Q_BLOCK) + a.shape[2:]), 0, 1) for a in q_arrays)
    out = lax.map(lambda args: fn(args[0], *args[1]), (jnp.arange(nb), xs))
    return jnp.swapaxes(out, 0, 1).reshape((b, s) + out.shape[3:])


def dsa_attention(q, k, v, q_idx, k_idx, w_idx):
    s_len = k.shape[1]
    top_k = min(DSA_TOPK_MAX, s_len // 4)

    def block(blk, qb, qib, wb):
        mask = chunk_mask(blk, s_len)
        rel = jax.nn.relu(jnp.einsum('bqhd,bsd->bqhs', qib, k_idx).astype(jnp.float32))
        score = jnp.einsum('bqh,bqhs->bqs', wb.astype(jnp.float32), rel) * DSA_IDX_SCALE
        score = jnp.where(mask[None], score, -jnp.inf)
        _, idx = lax.top_k(score, top_k)
        t = blk * Q_BLOCK + jnp.arange(Q_BLOCK)
        valid = (idx // CHUNK) <= (t // CHUNK)[None, :, None]
        k_sel = jax.vmap(lambda kb, ib: kb[ib])(k, idx)
        v_sel = jax.vmap(lambda vb, ib: vb[ib])(v, idx)
        logits = jnp.einsum('bqhd,bqkd->bqhk', qb, k_sel) * DSA_HEAD_DIM ** -0.5
        p = masked_softmax(logits, valid[:, :, None, :])
        return jnp.einsum('bqhk,bqkd->bqhd', p.astype(v.dtype), v_sel)

    return sweep_query_blocks(block, q, q_idx, w_idx)


def diff_attention(q, k, v, lam, lam_init, subln):
    s_len = k.shape[1]

    def block(blk, qb):
        mask = chunk_mask(blk, s_len)
        logits = jnp.einsum('bqhcd,bshcd->bhcqs', qb, k) * DIFF_QK_DIM ** -0.5
        p = masked_softmax(logits, mask)
        a = p[:, :, 0] - lam * p[:, :, 1]
        return jnp.einsum('bhqs,bshd->bqhd', a.astype(v.dtype), v)

    o = sweep_query_blocks(block, q)
    return rms_norm(o, subln) * (1.0 - lam_init)


def mla_attention(q_nope, q_rope, k_nope, k_rope, v):
    s_len = k_nope.shape[1]
    scale = (MLA_NOPE_DIM + MLA_ROPE_DIM) ** -0.5

    def block(blk, qn, qr):
        mask = chunk_mask(blk, s_len)
        logits = (jnp.einsum('bqhd,bshd->bhqs', qn, k_nope)
                  + jnp.einsum('bqhd,bsd->bhqs', qr, k_rope)) * scale
        p = masked_softmax(logits, mask)
        return jnp.einsum('bhqs,bshd->bqhd', p.astype(v.dtype), v)

    return sweep_query_blocks(block, q_nope, q_rope)


def hybrid_mixer(h, pos, layer, w_in, q_norm, w_uq, kv_norm, w_ukv,
                 lam_q1, lam_k1, lam_q2, lam_k2, subln, w_out):
    b, s, _ = h.shape
    f32 = jnp.float32
    rf = ROPE_FRACTION_DEN
    splits = np.cumsum(IN_SPLITS)[:-1].tolist()
    (q_a, k_a, v_a, q_i, k_i, w_i, q_b, k_b, v_b, c_q, c_kv, k_r) = jnp.split(h @ w_in, splits, axis=-1)
    q_a = rope(q_a.reshape(b, s, DSA_HEADS, DSA_HEAD_DIM), pos, DSA_HEAD_DIM // rf)
    k_a = rope(k_a, pos, DSA_HEAD_DIM // rf)
    q_i = rope(q_i.reshape(b, s, DSA_IDX_HEADS, DSA_IDX_DIM), pos, DSA_IDX_DIM // rf)
    k_i = rope(k_i, pos, DSA_IDX_DIM // rf)
    o_a = dsa_attention(q_a, k_a, v_a, q_i, k_i, w_i)
    q_b = rope(q_b.reshape(b, s, DIFF_HEADS, 2, DIFF_QK_DIM), pos, DIFF_QK_DIM // rf)
    k_b = rope(k_b.reshape(b, s, DIFF_HEADS, 2, DIFF_QK_DIM), pos, DIFF_QK_DIM // rf)
    v_b = v_b.reshape(b, s, DIFF_HEADS, DIFF_V_DIM)
    lam_init = 0.8 - 0.6 * math.exp(-0.3 * layer)
    lam = (jnp.exp(jnp.sum(lam_q1.astype(f32) * lam_k1.astype(f32)))
           - jnp.exp(jnp.sum(lam_q2.astype(f32) * lam_k2.astype(f32))) + lam_init)
    o_b = diff_attention(q_b, k_b, v_b, lam, lam_init, subln)
    q_c = (rms_norm(c_q, q_norm) @ w_uq).reshape(b, s, MLA_HEADS, MLA_NOPE_DIM + MLA_ROPE_DIM)
    q_nope = q_c[..., :MLA_NOPE_DIM]
    q_rope = rope(q_c[..., MLA_NOPE_DIM:], pos, MLA_ROPE_DIM)
    kv = (rms_norm(c_kv, kv_norm) @ w_ukv).reshape(b, s, MLA_HEADS, MLA_NOPE_DIM + MLA_V_DIM)
    k_nope = kv[..., :MLA_NOPE_DIM]
    v_c = kv[..., MLA_NOPE_DIM:]
    k_rope = rope(k_r, pos, MLA_ROPE_DIM)
    o_c = mla_attention(q_nope, q_rope, k_nope, k_rope, v_c)
    o = jnp.concatenate([o_a.reshape(b, s, -1), o_b.reshape(b, s, -1), o_c.reshape(b, s, -1)], axis=-1)
    return o @ w_out


def swiglu(h, wg, wu, wd):
    return (jax.nn.silu(h @ wg) * (h @ wu)) @ wd


def moe_ffn(h, router, wg, wu, wd):
    b, s, d = h.shape
    hf = h.reshape(-1, d)
    logits = (hf @ router).astype(jnp.float32)
    top_val, top_idx = lax.top_k(logits, MOE_TOP_K)
    gates = jax.nn.softmax(top_val, axis=-1)
    combine = jnp.sum(jax.nn.one_hot(top_idx, MOE_EXPERTS, dtype=jnp.float32) * gates[..., None], axis=1)
    out = jnp.zeros_like(hf)
    for e in range(MOE_EXPERTS):
        out = out + combine[:, e:e + 1].astype(h.dtype) * swiglu(hf, wg[e], wu[e], wd[e])
    return out.reshape(b, s, d)


def setup_inputs(seed: int = 0) -> dict:
    key = jax.random.key(seed)
    ks = jax.random.split(key, 24)
    f32 = jnp.float32

    def w(k, shape, fan_in):
        return jax.random.normal(k, shape, f32) * fan_in ** -0.5

    def gain(k, shape):
        return 1.0 + 0.02 * jax.random.normal(k, shape, f32)

    x = jax.random.normal(ks[0], (BATCH, SEQ, D_MODEL), f32)
    offsets = jax.random.randint(ks[1], (BATCH,), 0, 64) * CHUNK
    positions = (offsets[:, None] + jnp.arange(SEQ)[None, :]).astype(jnp.int32)
    return {
        'x': x,
        'positions': positions,
        'attn_norm': gain(ks[2], (DEPTH, D_MODEL)),
        'w_in': w(ks[3], (DEPTH, D_MODEL, N_IN), D_MODEL),
        'mla_q_norm': gain(ks[4], (DEPTH, MLA_Q_LORA)),
        'w_uq': w(ks[5], (DEPTH, MLA_Q_LORA, MLA_HEADS * (MLA_NOPE_DIM + MLA_ROPE_DIM)), MLA_Q_LORA),
        'mla_kv_norm': gain(ks[6], (DEPTH, MLA_KV_LORA)),
        'w_ukv': w(ks[7], (DEPTH, MLA_KV_LORA, MLA_HEADS * (MLA_NOPE_DIM + MLA_V_DIM)), MLA_KV_LORA),
        'diff_lambda_q1': 0.1 * jax.random.normal(ks[8], (DEPTH, DIFF_QK_DIM), f32),
        'diff_lambda_k1': 0.1 * jax.random.normal(ks[9], (DEPTH, DIFF_QK_DIM), f32),
        'diff_lambda_q2': 0.1 * jax.random.normal(ks[10], (DEPTH, DIFF_QK_DIM), f32),
        'diff_lambda_k2': 0.1 * jax.random.normal(ks[11], (DEPTH, DIFF_QK_DIM), f32),
        'diff_subln': gain(ks[12], (DEPTH, DIFF_V_DIM)),
        'w_out': w(ks[13], (DEPTH, D_MIX, D_MODEL), D_MIX),
        'ffn_norm': gain(ks[14], (DEPTH, D_MODEL)),
        'dense_w_gate': w(ks[15], (N_DENSE, D_MODEL, D_FF), D_MODEL),
        'dense_w_up': w(ks[16], (N_DENSE, D_MODEL, D_FF), D_MODEL),
        'dense_w_down': w(ks[17], (N_DENSE, D_FF, D_MODEL), D_FF),
        'moe_router': w(ks[18], (N_MOE, D_MODEL, MOE_EXPERTS), D_MODEL),
        'moe_w_gate': w(ks[19], (N_MOE, MOE_EXPERTS, D_MODEL, MOE_D_FF), D_MODEL),
        'moe_w_up': w(ks[20], (N_MOE, MOE_EXPERTS, D_MODEL, MOE_D_FF), D_MODEL),
        'moe_w_down': w(ks[21], (N_MOE, MOE_EXPERTS, MOE_D_FF, D_MODEL), MOE_D_FF),
        'final_norm': gain(ks[22], (D_MODEL,)),
    }


def reference(x, positions, attn_norm, w_in, mla_q_norm, w_uq, mla_kv_norm, w_ukv,
              diff_lambda_q1, diff_lambda_k1, diff_lambda_q2, diff_lambda_k2, diff_subln,
              w_out, ffn_norm, dense_w_gate, dense_w_up, dense_w_down,
              moe_router, moe_w_gate, moe_w_up, moe_w_down, final_norm):
    h = x
    for layer in range(DEPTH):
        h = h + hybrid_mixer(rms_norm(h, attn_norm[layer]), positions, layer, w_in[layer],
                             mla_q_norm[layer], w_uq[layer], mla_kv_norm[layer], w_ukv[layer],
                             diff_lambda_q1[layer], diff_lambda_k1[layer],
                             diff_lambda_q2[layer], diff_lambda_k2[layer],
                             diff_subln[layer], w_out[layer])
        hn = rms_norm(h, ffn_norm[layer])
        j = layer // 2
        if layer % 2 == 0:
            h = h + swiglu(hn, dense_w_gate[j], dense_w_up[j], dense_w_down[j])
        else:
            h = h + moe_ffn(hn, moe_router[j], moe_w_gate[j], moe_w_up[j], moe_w_down[j])
    return rms_norm(h, final_norm)
```

```cpp
#include <hip/hip_runtime.h>
#include <hip/hip_bf16.h>
#include <cstdio>
#include <cstdint>
#include <cmath>

#define GAS __attribute__((address_space(1)))
#define LAS __attribute__((address_space(3)))
typedef unsigned short bf16_t;
typedef short bf16x8 __attribute__((ext_vector_type(8)));
typedef short s16x4 __attribute__((ext_vector_type(4)));
typedef float f32x4 __attribute__((ext_vector_type(4)));
typedef float f32x2 __attribute__((ext_vector_type(2)));
typedef float f32x16 __attribute__((ext_vector_type(16)));
typedef unsigned u32x4 __attribute__((ext_vector_type(4)));
typedef unsigned u32x2 __attribute__((ext_vector_type(2)));
typedef __bf16 bf16x2_t __attribute__((ext_vector_type(2)));
typedef int i32x4 __attribute__((ext_vector_type(4)));
typedef int i32x8 __attribute__((ext_vector_type(8)));
#define DI __device__ __forceinline__

constexpr int NB = 16, SEQ = 2048, DM = 1024, MTOK = NB * SEQ;
constexpr int NIN = 2152, PP = 2176;
constexpr int DFF = 3584, NEXP = 8;
constexpr float EPS = 1e-6f;
constexpr int TQA = 0, TQI = 256, TQB = 768, TKB = 1024, TVB = 1280, TCQ = 1536, TCKV = 1792, TKA = 1920, TVA = 1984, TKI = 2048, TKR = 2112, TWI = 2144;
constexpr int NINP = 2304;
constexpr int NFREQ = 28;
constexpr int CSW = 2 * NFREQ;
constexpr int MAXSLOT_TILES = 272;
constexpr int MAXSLOTS = MAXSLOT_TILES * 256;

constexpr size_t MiB = 1u << 20;
constexpr size_t WS_CTL = 0, CTL_ZERO_BYTES = 128 * 1024;
constexpr size_t WS_CS = 1 * MiB;
constexpr size_t WS_SSQA = 8 * MiB;
constexpr size_t WS_SSQH = 10 * MiB;
constexpr size_t WS_SSQCQ = 12 * MiB;
constexpr size_t WS_SSQCKV = 12 * MiB + 512 * 1024;
constexpr size_t WS_RSTDTOK = 13 * MiB;
constexpr size_t WS_TOKLIST = 13 * MiB + 128 * 1024;
constexpr size_t WS_TOKPOS = 13 * MiB + 384 * 1024;
constexpr size_t WS_TOKGATE = 13 * MiB + 640 * 1024;
constexpr size_t WS_ROWTOK = 14 * MiB;
constexpr size_t WS_ROWGATE = 14 * MiB + 512 * 1024;
constexpr size_t WS_WSMALL = 20 * MiB;
constexpr size_t WS_RA = 60 * MiB;
constexpr size_t WS_BIG = 124 * MiB;
constexpr size_t WS_P = WS_BIG;
constexpr size_t WS_QC = WS_BIG + 136 * MiB;
constexpr size_t WS_KV = WS_BIG + 184 * MiB;
constexpr size_t WS_MASK = WS_BIG + 248 * MiB;
constexpr size_t WS_HB8 = WS_BIG;
constexpr size_t WS_ACT8 = WS_BIG + 32 * MiB;
constexpr size_t WS_WMOE = WS_BIG + 270 * MiB;
constexpr size_t WS_END = WS_BIG + 354 * MiB;
constexpr size_t WS_SBD = 15 * MiB;
constexpr size_t WS_SBM = 15 * MiB + 64 * 1024;
constexpr size_t WB_IN = (size_t)NINP * 1024 * 2, WB_UQ = 768 * 256 * 2, WB_UKV = 1024 * 256 * 2, WB_OUT = 1024 * 1024 * 2, WB_GU = (size_t)2 * DFF * 1024, WB_D = (size_t)1024 * DFF;
constexpr size_t WO_IN0 = 0, WO_UQ0 = WO_IN0 + WB_IN, WO_UKV0 = WO_UQ0 + WB_UQ, WO_OUT0 = WO_UKV0 + WB_UKV, WO_L1 = WO_OUT0 + WB_OUT;
constexpr size_t WO_GU = 2 * WO_L1, WO_D = WO_GU + WB_GU, WO_END = WO_D + WB_D;
static_assert(WO_END <= 40 * MiB, "small weights fit");
static_assert((size_t)NEXP * (WB_GU + WB_D) <= 84 * MiB, "moe weights fit");
static_assert((size_t)MAXSLOTS * DFF <= 238 * MiB, "act fits");
constexpr float ACT_SCALE = 8.0f, WD_SCALE = 64.0f;
constexpr float LOG2E = 1.4426950408889634f;
constexpr float QS_DSA = 0.125f * LOG2E, QS_DIFF = 0.17677669529663687f * LOG2E, QS_MLA = 0.10206207261596575f * LOG2E;
constexpr int CW_TMO = 0, CW_CODE = 1, CW_BAR = 4096, CW_QUEUE = 8192  , CW_ECNT = 12288  , CW_FLAGS = 16384  ;

constexpr int RING_BYTES = 131072, MISC_OFF = RING_BYTES + 320, LDS_BYTES = 147456;
constexpr int ROWTAB_OFF = RING_BYTES + 4096;
constexpr int LDSX_OFF = RING_BYTES + 1024;

#define RLX_AGENT __ATOMIC_RELAXED, __HIP_MEMORY_SCOPE_AGENT
DI unsigned f2bf(float f) { unsigned u = __builtin_bit_cast(unsigned, f); return (u + 0x7fffu + ((u >> 16) & 1u)) >> 16; }
DI unsigned pk2(float lo, float hi) { f32x2 v = {lo, hi}; bf16x2_t b = __builtin_convertvector(v, bf16x2_t); return __builtin_bit_cast(unsigned, b); }
DI float bf2f(unsigned short h) { return __builtin_bit_cast(float, (unsigned)h << 16); }
DI float wave_sum(float v) {
#pragma unroll
    for (int o = 1; o < 64; o <<= 1) v += __shfl_xor(v, o);
    return v;
}

#define XB_TMO      128
#define XB_XCNT(j)  (256  + 64 * (j))
#define XB_XSUB(j)  (1280 + 64 * (j))
#define XB_XGEN(j)  (2304 + 64 * (j))
#define XB_TOP      3328
#define XB_TOPGEN   3392
#define XCD_BAR_WORDS 3456
#define XB_SPIN_CAP (1u << 18)
DI unsigned xb_ld(unsigned* p)              { return __hip_atomic_load(p, __ATOMIC_RELAXED, __HIP_MEMORY_SCOPE_AGENT); }
DI unsigned xb_add(unsigned* p, unsigned v) { return __hip_atomic_fetch_add(p, v, __ATOMIC_RELAXED, __HIP_MEMORY_SCOPE_AGENT); }
DI unsigned xb_xcc_id() { return (unsigned)__builtin_amdgcn_s_getreg((3 << 11) | 20) & 0xFu; }
#define XB_SPIN(cond, bar) do { unsigned _sp = 0; while (cond) { __builtin_amdgcn_s_sleep(1); \
    if ((++_sp & 255u) == 0u) { if (xb_ld(&(bar)[XB_TMO])) break; if (_sp > XB_SPIN_CAP) { atomicAdd(&(bar)[XB_TMO], 1u); break; } } } } while (0)
struct XcdBarrier { unsigned* bar; unsigned x; volatile LAS unsigned* st; };
DI XcdBarrier xcd_barrier_post(unsigned* bar, volatile LAS unsigned* st) {
    XcdBarrier b; b.bar = bar; b.x = xb_xcc_id(); b.st = st;
    if (threadIdx.x == 0) (void)xb_add(&bar[XB_XCNT(b.x)], 1u);
    return b;
}
DI void xcd_barrier_complete(unsigned* bar, unsigned x, unsigned& nloc, unsigned& nx) {
    const unsigned G = gridDim.x * gridDim.y * gridDim.z;
    unsigned sum, cnt, mine, sp = 0u;
    for (;;) {
        sum = 0u; cnt = 0u; mine = 0u;
#pragma unroll
        for (unsigned j = 0; j < 16; ++j) { const unsigned c = xb_ld(&bar[XB_XCNT(j)]); sum += c; cnt += (c > 0u) ? 1u : 0u; mine = (j == x) ? c : mine; }
        if (sum == G) break;
        __builtin_amdgcn_s_sleep(1);
        if ((++sp & 255u) == 0u) { if (xb_ld(&bar[XB_TMO])) break; if (sp > XB_SPIN_CAP) { atomicAdd(&bar[XB_TMO], 1u); break; } }
    }
    nloc = mine > 0u ? mine : 1u; nx = cnt > 0u ? cnt : 1u;
}
DI void xcd_barrier(const XcdBarrier& b) {
    asm volatile("s_waitcnt vmcnt(0)" ::: "memory");
    __syncthreads();
    if (threadIdx.x == 0) {
        unsigned* bar = b.bar;
        __builtin_amdgcn_s_waitcnt(0);
        unsigned nloc = b.st[0], nx = b.st[1];
        if (nloc == 0u) { xcd_barrier_complete(bar, b.x, nloc, nx); b.st[0] = nloc; b.st[1] = nx; }
        const unsigned old = xb_add(&bar[XB_XSUB(b.x)], 1u);
        const unsigned gen = old / nloc;
        if (old + 1u == (gen + 1u) * nloc) {
            __builtin_amdgcn_fence(__ATOMIC_RELEASE, "agent");
            asm volatile("s_waitcnt vmcnt(0)" ::: "memory");
            const unsigned og = xb_add(&bar[XB_TOP], 1u);
            const unsigned tg = og / nx;
            if (og + 1u == (tg + 1u) * nx) xb_add(&bar[XB_TOPGEN], 1u);
            else XB_SPIN(xb_ld(&bar[XB_TOPGEN]) == tg, bar);
            __builtin_amdgcn_fence(__ATOMIC_ACQUIRE, "agent");
            xb_add(&bar[XB_XGEN(b.x)], 1u);
            asm volatile("s_waitcnt vmcnt(0)" ::: "memory");
        } else {
            XB_SPIN(xb_ld(&bar[XB_XGEN(b.x)]) == gen, bar);
            __builtin_amdgcn_fence(__ATOMIC_ACQUIRE, "agent");
            asm volatile("s_waitcnt vmcnt(0)" ::: "memory");
        }
    }
    __syncthreads();
}

namespace pg8 {
constexpr int BM = 256, BK = 64, HALF = 128, HTB = HALF * BK * 2, STAGE_BYTES = 8 * HTB, NXCD = 8, WGM = 8;
__host__ __device__ __forceinline__ int lds_byte(int r, int c) { const int st = (r >> 4) * 2 + (c >> 5), rr = r & 15, cc = c & 31, ob = rr * 64 + cc * 2; return st * 1024 + (ob ^ (((ob >> 9) & 1) << 5)); }
__host__ __device__ __forceinline__ void stage_rc(int b, int& R, int& C) { const int st = b / 1024, sb = b % 1024, swz = sb ^ (((sb >> 9) & 1) << 5); R = (st >> 1) * 16 + swz / 64; C = (st & 1) * 32 + (swz % 64) / 2; }
__host__ __device__ __forceinline__ int perm32(int rho) { const int n = rho >> 4, i = rho & 15; return 8 * (i >> 2) + 4 * n + (i & 3); }
struct Unit { int pm, pn; };
struct TileOrder {
    int nM, nN, nwg, G, c, pm0;
    DI void init(int nM_, int nN_, int G_, int c_, int pm0_) { nM = nM_; nN = nN_; nwg = nM * nN; G = G_; c = c_; pm0 = pm0_; }
    DI bool next(int i, Unit& u) const {
        const long L = (long)i * G + c; if (L >= nwg) return false;
        int wgid = (int)L; { const int q = nwg / NXCD, r = nwg % NXCD, xcd = wgid % NXCD, off = wgid / NXCD; wgid = (xcd < r ? xcd * (q + 1) : r * (q + 1) + (xcd - r) * q) + off; }
        const int nig = WGM * nN, gid = wgid / nig, fm = gid * WGM, gsz = (nM - fm) < WGM ? (nM - fm) : WGM;
        u.pm = pm0 + fm + ((wgid % nig) % gsz); u.pn = (wgid % nig) / gsz; return true;
    }
};
template <class E> struct EpiSignals { static constexpr bool on = false; };
template <int MODE> struct AccT { typedef f32x4 type; };
template <> struct AccT<1> { typedef i32x4 type; };
template <int MODE, class Epi, class Sched, bool ALIGN_EPI>
DI void gemm_phase(LAS unsigned char* lds, const int KB, const Sched& S, const Epi& E) {
    typedef typename AccT<MODE>::type acc_t;
    constexpr bool GA = Sched::GATHER;
    int tid_ = threadIdx.x; asm volatile("" : "+v"(tid_));
    const int tid = tid_, wid = __builtin_amdgcn_readfirstlane(tid >> 6), lane = tid & 63, wr = wid >> 2, wc = wid & 3, fr = lane & 15, fq = lane >> 4;
    const int nt = KB / 128;
    unsigned cvo[2][2] = {{0u, 0u}, {0u, 0u}}, nvo[2][2] = {{0u, 0u}, {0u, 0u}};
    unsigned voA, voB;
    { int R, C; stage_rc(tid * 16, R, C); voA = (unsigned)R * S.lda2 + (unsigned)C * 2u; voB = (unsigned)(((R & ~31) + perm32(R & 31)) * KB) + (unsigned)C * 2u; }
    const size_t q64A = (size_t)64 * S.lda2, q64B = (size_t)64 * KB;
    const unsigned kstep = (unsigned)(BK * 2);
    const size_t hstepB = (size_t)HALF * KB;
    const unsigned ldsw = (unsigned)wid * 1024u;
    const int aoff = lds_byte(wr * 64 + fr, fq * 8), boff = lds_byte(wc * 32 + fr, fq * 8);
#define PG8_SA(b, h) (((b) * 2 + (h)) * HTB)
#define PG8_SB(b, h) ((4 + (b) * 2 + (h)) * HTB)
#define PG8_STAGEB(bufoff, gbase) do { \
        __builtin_amdgcn_global_load_lds((const unsigned*)((const char*)(gbase) + voB), (LAS unsigned*)(lds + (bufoff) + ldsw), 16, 0, 0); \
        __builtin_amdgcn_global_load_lds((const unsigned*)((const char*)(gbase) + q64B + voB), (LAS unsigned*)(lds + (bufoff) + ldsw + 8192), 16, 0, 0); } while (0)
#define PG8_STAGEA(bufoff, gbase, o0, o1) do { \
        __builtin_amdgcn_global_load_lds((const unsigned*)((const char*)(gbase) + (o0)), (LAS unsigned*)(lds + (bufoff) + ldsw), 16, 0, 0); \
        __builtin_amdgcn_global_load_lds((const unsigned*)((const char*)(gbase) + (o1)), (LAS unsigned*)(lds + (bufoff) + ldsw + 8192), 16, 0, 0); } while (0)
#define PG8_STAGEAH(bufoff, gbase, h) do { if (GA) PG8_STAGEA(bufoff, gbase, cvo[h][0], cvo[h][1]); else { \
        __builtin_amdgcn_global_load_lds((const unsigned*)((const char*)(gbase) + (size_t)((h) * 2) * q64A + voA), (LAS unsigned*)(lds + (bufoff) + ldsw), 16, 0, 0); \
        __builtin_amdgcn_global_load_lds((const unsigned*)((const char*)(gbase) + (size_t)((h) * 2 + 1) * q64A + voA), (LAS unsigned*)(lds + (bufoff) + ldsw + 8192), 16, 0, 0); } } while (0)
#define PG8_GOFF(dst, u) do { _Pragma("unroll") for (int _i = 0; _i < 2; ++_i) { int R_, C_; stage_rc(tid * 16 + _i * 8192, R_, C_); \
        dst[0][_i] = S.a_row_off(u, R_) + (unsigned)C_ * 2u; dst[1][_i] = S.a_row_off(u, R_ + HALF) + (unsigned)C_ * 2u; } } while (0)
#define PG8_LD8(p) __builtin_shufflevector(*(const LAS i32x4*)(p), *(const LAS i32x4*)((p) + 1024), 0, 1, 2, 3, 4, 5, 6, 7)
#define PG8_LDA(dst, b, h) do { _Pragma("unroll") for (int m = 0; m < 4; ++m) dst[m] = PG8_LD8(lds + PG8_SA(b, h) + aoff + m * 2048); } while (0)
#define PG8_LDB(dst, b, h) do { _Pragma("unroll") for (int n = 0; n < 2; ++n) dst[n] = PG8_LD8(lds + PG8_SB(b, h) + boff + n * 2048); } while (0)
#define PG8_LO(x) __builtin_shufflevector((x), (x), 0, 1, 2, 3)
#define PG8_HI(x) __builtin_shufflevector((x), (x), 4, 5, 6, 7)
#define PG8_MMA(ai, bj, At, Bt) do { __builtin_amdgcn_s_setprio(1); _Pragma("unroll") for (int m = 0; m < 4; ++m) _Pragma("unroll") for (int n = 0; n < 2; ++n) { \
        if constexpr (MODE == 0) { acc[ai][bj][m][n] = __builtin_amdgcn_mfma_f32_16x16x32_bf16(__builtin_bit_cast(bf16x8, PG8_LO(Bt[n])), __builtin_bit_cast(bf16x8, PG8_LO(At[m])), acc[ai][bj][m][n], 0, 0, 0); \
                                   acc[ai][bj][m][n] = __builtin_amdgcn_mfma_f32_16x16x32_bf16(__builtin_bit_cast(bf16x8, PG8_HI(Bt[n])), __builtin_bit_cast(bf16x8, PG8_HI(At[m])), acc[ai][bj][m][n], 0, 0, 0); } \
        else if constexpr (MODE == 1) { acc[ai][bj][m][n] = __builtin_amdgcn_mfma_i32_16x16x64_i8(PG8_LO(Bt[n]), PG8_LO(At[m]), acc[ai][bj][m][n], 0, 0, 0); \
                                        acc[ai][bj][m][n] = __builtin_amdgcn_mfma_i32_16x16x64_i8(PG8_HI(Bt[n]), PG8_HI(At[m]), acc[ai][bj][m][n], 0, 0, 0); } \
        else { asm volatile("v_mfma_scale_f32_16x16x128_f8f6f4 %0, %1, %2, %0, %3, %3 op_sel_hi:[0,0,0]" : "+v"(acc[ai][bj][m][n]) : "v"(Bt[n]), "v"(At[m]), "v"(0x7f7f7f7f)); } } __builtin_amdgcn_s_setprio(0); } while (0)
#define PG8_WAIT_V(n) asm volatile("s_waitcnt vmcnt(" #n ")" ::: "memory")
#define PG8_WAIT_L(n) asm volatile("s_waitcnt lgkmcnt(" #n ")" ::: "memory")
#define PG8_BAR __builtin_amdgcn_s_barrier()
#define PG8_SCHED __builtin_amdgcn_sched_barrier(0)
    Unit cur, nxt; int ui = 0;
    if (!S.next(0, cur)) return;
    LAS float* rtab = (LAS float*)(lds + ROWTAB_OFF);
    { typename Epi::Info inf0 = E.info_load(cur, tid); E.info_store(rtab, tid, inf0); }
    acc_t acc[2][2][4][2];
#pragma unroll
    for (int a = 0; a < 2; ++a)
#pragma unroll
        for (int b = 0; b < 2; ++b)
#pragma unroll
            for (int m = 0; m < 4; ++m)
#pragma unroll
                for (int n = 0; n < 2; ++n) acc[a][b][m][n] = (acc_t){0, 0, 0, 0};
    i32x8 At[4], B0[2], B1[2];
    if (GA) PG8_GOFF(cvo, cur);
    const char* cA = S.a_base(cur); const char* cB = S.b_base(cur);
    PG8_STAGEB(PG8_SB(0, 0), cB); PG8_STAGEB(PG8_SB(0, 1), cB + hstepB); PG8_STAGEAH(PG8_SA(0, 0), cA, 0); PG8_STAGEAH(PG8_SA(0, 1), cA, 1);
    if (wr == 1) PG8_BAR;
    PG8_WAIT_V(2); PG8_BAR;
    PG8_STAGEB(PG8_SB(1, 0), cB + kstep); PG8_STAGEAH(PG8_SA(1, 0), cA + kstep, 0); PG8_STAGEB(PG8_SB(1, 1), cB + hstepB + kstep);
    PG8_WAIT_V(6); PG8_BAR;
    for (;;) {
        const bool has_next = S.next(ui + 1, nxt);
        const char* nA = has_next ? S.a_base(nxt) : cA; const char* nB = has_next ? S.b_base(nxt) : cB;
        if (GA) { if (has_next) PG8_GOFF(nvo, nxt); else {
#pragma unroll
            for (int h = 0; h < 2; ++h)
#pragma unroll
                for (int i = 0; i < 2; ++i) nvo[h][i] = cvo[h][i]; } }
#pragma unroll 1
        for (int t = 0; t < nt; t += 2) {
            const bool last = (t == nt - 2);
            const char* a1 = cA + (size_t)(t + 1) * kstep;
            const char* a2 = last ? nA : cA + (size_t)(t + 2) * kstep; const char* b2 = last ? nB : cB + (size_t)(t + 2) * kstep;
            const char* a3 = a2 + kstep; const char* b3 = b2 + kstep;
            PG8_LDB(B0, 0, 0); PG8_LDB(B1, 0, 1); PG8_SCHED; PG8_LDA(At, 0, 0); PG8_STAGEAH(PG8_SA(1, 1), a1, 1);
            if (GA) { if (last) { cvo[0][0] = nvo[0][0]; cvo[0][1] = nvo[0][1]; cvo[1][0] = nvo[1][0]; cvo[1][1] = nvo[1][1]; } }
            PG8_WAIT_V(8); PG8_WAIT_L(0); PG8_BAR; PG8_MMA(0, 0, At, B0); PG8_MMA(0, 1, At, B1); PG8_BAR; PG8_SCHED;
            PG8_LDA(At, 0, 1); PG8_STAGEB(PG8_SB(0, 0), b2); PG8_STAGEB(PG8_SB(0, 1), b2 + hstepB); PG8_STAGEAH(PG8_SA(0, 0), a2, 0);
            PG8_WAIT_V(8); PG8_WAIT_L(0); PG8_BAR; PG8_MMA(1, 0, At, B0); PG8_MMA(1, 1, At, B1); PG8_BAR; PG8_SCHED;
            PG8_LDB(B0, 1, 0); PG8_LDB(B1, 1, 1); PG8_SCHED; PG8_LDA(At, 1, 0); PG8_STAGEAH(PG8_SA(0, 1), a2, 1);
            PG8_WAIT_V(8); PG8_WAIT_L(0); PG8_BAR; PG8_MMA(0, 0, At, B0); PG8_MMA(0, 1, At, B1); PG8_BAR; PG8_SCHED;
            PG8_LDA(At, 1, 1); PG8_STAGEB(PG8_SB(1, 0), b3); PG8_STAGEB(PG8_SB(1, 1), b3 + hstepB); PG8_STAGEAH(PG8_SA(1, 0), a3, 0);
            PG8_WAIT_V(8); PG8_WAIT_L(0); PG8_BAR; PG8_MMA(1, 0, At, B0); PG8_MMA(1, 1, At, B1); PG8_BAR; PG8_SCHED;
        }
        if constexpr (ALIGN_EPI) { if (wr == 0) PG8_BAR; }
        if constexpr (MODE == 2) asm volatile("s_nop 15\n\ts_nop 15" ::: "memory");
        typename Epi::Info ninf = E.info_load(has_next ? nxt : cur, tid);
        E(acc, cur, wr, wc, fr, fq, rtab + (ui & 1) * 512);
        if constexpr (EpiSignals<Epi>::on) {
            if (E.signals(cur)) {
                asm volatile("s_waitcnt vmcnt(0)" ::: "memory"); PG8_BAR;
                if (wid == 0) { __builtin_amdgcn_fence(__ATOMIC_RELEASE, "agent"); if (lane == 0) (void)__hip_atomic_fetch_add(E.flag(cur), 1u, __ATOMIC_RELAXED, __HIP_MEMORY_SCOPE_AGENT); }
            }
        }
        if (!has_next) break;
        E.info_store(rtab + ((ui + 1) & 1) * 512, tid, ninf);
#pragma unroll
        for (int a = 0; a < 2; ++a)
#pragma unroll
            for (int b = 0; b < 2; ++b)
#pragma unroll
                for (int m = 0; m < 4; ++m)
#pragma unroll
                    for (int n = 0; n < 2; ++n) acc[a][b][m][n] = (acc_t){0, 0, 0, 0};
        cur = nxt; cA = nA; cB = nB; ++ui;
        if (GA) {
#pragma unroll
            for (int h = 0; h < 2; ++h)
#pragma unroll
                for (int i = 0; i < 2; ++i) cvo[h][i] = nvo[h][i]; }
        if constexpr (ALIGN_EPI) { if (wr == 1) PG8_BAR; }
    }
    PG8_WAIT_V(0);
    if constexpr (!ALIGN_EPI) { if (wr == 0) PG8_BAR; }
    PG8_BAR;
#undef PG8_SA
#undef PG8_SB
#undef PG8_STAGEA
#undef PG8_STAGEAH
#undef PG8_STAGEB
#undef PG8_GOFF
#undef PG8_LDA
#undef PG8_LD8
#undef PG8_LO
#undef PG8_HI
#undef PG8_LDB
#undef PG8_MMA
#undef PG8_WAIT_V
#undef PG8_WAIT_L
#undef PG8_BAR
#undef PG8_SCHED
}
}

struct SchedDense {
    static constexpr bool GATHER = false;
    pg8::TileOrder T; unsigned lda2; int arow0; const char* A; const char* Bt; size_t btile;
    DI bool next(int i, pg8::Unit& u) const { return T.next(i, u); }
    DI const char* a_base(const pg8::Unit& u) const { return A + (size_t)(u.pm * 256 - arow0) * lda2; }
    DI unsigned a_row_off(const pg8::Unit&, int) const { return 0u; }
    DI const char* b_base(const pg8::Unit& u) const { return Bt + (size_t)u.pn * btile; }
};
struct SchedMoeGU {
    static constexpr bool GATHER = true;
    pg8::TileOrder T; unsigned lda2; const char* A; const int* rowtok; const LAS int* tile_e; const char* Bt; size_t btile, estride;
    DI bool next(int i, pg8::Unit& u) const { return T.next(i, u); }
    DI const char* a_base(const pg8::Unit&) const { return A; }
    DI unsigned a_row_off(const pg8::Unit& u, int r) const { int t = rowtok[u.pm * 256 + r]; t = t < 0 ? 0 : t; return (unsigned)t * lda2; }
    DI const char* b_base(const pg8::Unit& u) const { return Bt + (size_t)(tile_e[u.pm] & 7) * estride + (size_t)u.pn * btile; }
};
struct SchedMoeD {
    static constexpr bool GATHER = false;
    pg8::TileOrder T; unsigned lda2; int arow0; const char* A; const LAS int* tile_e; const char* Bt; size_t btile, estride;
    DI bool next(int i, pg8::Unit& u) const { return T.next(i, u); }
    DI const char* a_base(const pg8::Unit& u) const { return A + (size_t)(u.pm * 256 - arow0) * lda2; }
    DI unsigned a_row_off(const pg8::Unit&, int) const { return 0u; }
    DI const char* b_base(const pg8::Unit& u) const { return Bt + (size_t)(tile_e[u.pm] & 7) * estride + (size_t)u.pn * btile; }
};

DI int perm64(int p) { if (p >= 16) return p; const int g = p >> 3, e = p & 7; return e < 4 ? 4 * g + e : 8 + 4 * g + (e - 4); }
DI int perm32r(int p) { const int g = p >> 3, e = p & 7; return e < 4 ? 4 * g + e : 16 + 4 * g + (e - 4); }
DI int win_src_col(int n) {
    if (n < 256) return ((n >> 6) << 6) + perm64(n & 63);
    if (n < 768) { const int q = n - 256; return 384 + ((q >> 6) << 6) + perm64(q & 63); }
    if (n < 1024) return 968 + (n - 768);
    if (n < 1280) return 1224 + (n - 1024);
    if (n < 1536) return 1480 + (n - 1280);
    if (n < 1792) return 1736 + (n - 1536);
    if (n < 1920) return 1992 + (n - 1792);
    if (n < 1984) return 256 + perm64(n - 1920);
    if (n < 2048) return 320 + (n - 1984);
    if (n < 2112) return 896 + perm64(n - 2048);
    if (n < 2144) return 2120 + perm32r(n - 2112);
    if (n < 2152) return 960 + (n - 2144);
    return -1;
}
DI int win_rope_off(int n) {
    if (n < 768) { const int p = n & 63; return p == 0 ? 0 : (p == 8 ? 4 : -1); }
    if (n < 1280) return (n & 31) == 0 ? 8 : -1;
    if (n >= 1920 && n < 1984) { const int p = n - 1920; return p == 0 ? 0 : (p == 8 ? 4 : -1); }
    if (n >= 2048 && n < 2112) { const int p = n - 2048; return p == 0 ? 0 : (p == 8 ? 4 : -1); }
    if (n >= 2112 && n < 2144) return 12 + 4 * ((n - 2112) >> 3);
    return -1;
}
DI int wuq_src_col(int n) { const int hh = n / 96, p = n % 96; return hh * 96 + (p < 64 ? p : 64 + perm32r(p - 64)); }
DI int wuq_rope_off(int n) { const int p = n % 96; return p >= 64 ? 12 + 4 * ((p - 64) >> 3) : -1; }

typedef const f32x4 (&AccRef)[2][2][4][2];
DI float sum16(const float* p) { const f32x4 a = *(const f32x4*)p, b = *(const f32x4*)(p + 4), c = *(const f32x4*)(p + 8), d = *(const f32x4*)(p + 12);
    return ((a[0] + a[1]) + (a[2] + a[3])) + ((b[0] + b[1]) + (b[2] + b[3])) + (((c[0] + c[1]) + (c[2] + c[3])) + ((d[0] + d[1]) + (d[2] + d[3]))); }
DI float sum4(const float* p) { const f32x4 a = *(const f32x4*)p; return (a[0] + a[1]) + (a[2] + a[3]); }
DI u32x4 pack8(const f32x4 v0, const f32x4 v1) { u32x4 w; w.x = pk2(v0[0], v0[1]); w.y = pk2(v0[2], v0[3]); w.z = pk2(v1[0], v1[1]); w.w = pk2(v1[2], v1[3]); return w; }
DI float dot4(const f32x4 a) { return (a[0] * a[0] + a[1] * a[1]) + (a[2] * a[2] + a[3] * a[3]); }

struct NoInfo { };
struct EpiIn {
    struct Info { float s; };
    bf16_t* P; const float* ssqA; const float* cs; float* ssqCQ; float* ssqCKV; unsigned* flg;
    DI bool signals(const pg8::Unit& u) const { return u.pn == 6 || u.pn == 7; }
    DI unsigned* flag(const pg8::Unit& u) const { return flg + 16 * (u.pm * 2 + (u.pn - 6)); }
    DI Info info_load(const pg8::Unit& u, int tid) const { const float* p = ssqA + (size_t)(u.pm * 256 + (tid >> 1)) * 16 + 8 * (tid & 1); const f32x4 a = *(const f32x4*)p, b = *(const f32x4*)(p + 4);
        return Info{((a[0] + a[1]) + (a[2] + a[3])) + ((b[0] + b[1]) + (b[2] + b[3]))}; }
    DI void info_store(LAS float* tab, int tid, const Info& i) const { float s = i.s; s += __shfl_xor(s, 1); if (!(tid & 1)) tab[tid >> 1] = 1.0f / sqrtf(s * (1.0f / 1024.0f) + EPS); }
    DI void operator()(AccRef acc, const pg8::Unit& u, int wr, int wc, int fr, int fq, const LAS float* tab) const {
        const int colb = u.pn * 256 + wc * 32 + 8 * fq;
        int ro[2];
#pragma unroll
        for (int bj = 0; bj < 2; ++bj) ro[bj] = win_rope_off(colb + bj * 128);
        const bool sq_cq = (u.pn == 6), sq_ckv = (u.pn == 7);
        const float qsc = (u.pn == 0) ? QS_DSA : (u.pn == 3) ? QS_DIFF : 1.0f;
#pragma unroll
        for (int ai = 0; ai < 2; ++ai)
#pragma unroll
            for (int m = 0; m < 4; ++m) {
                int rr = ai * 128 + wr * 64 + m * 16 + fr; asm volatile("" : "+v"(rr));
                const int row = u.pm * 256 + rr;
                const float rstd = tab[rr];
                float sq = 0.f;
#pragma unroll
                for (int bj = 0; bj < 2; ++bj) {
                    f32x4 v0 = acc[ai][bj][m][0] * rstd, v1 = acc[ai][bj][m][1] * rstd;
                    if (ro[bj] >= 0) {
                        const f32x4 c4 = *(const f32x4*)(cs + (size_t)row * CSW + ro[bj]), s4 = *(const f32x4*)(cs + (size_t)row * CSW + NFREQ + ro[bj]);
                        const f32x4 n0 = v0 * c4 - v1 * s4, n1 = v1 * c4 + v0 * s4; v0 = n0; v1 = n1;
                    }
                    if (sq_cq || (sq_ckv && bj == 0)) sq += dot4(v0) + dot4(v1);
                    if (qsc != 1.0f) { v0 = v0 * qsc; v1 = v1 * qsc; }
                    const int col = colb + bj * 128;
                    if (col < PP) *(u32x4*)(P + (size_t)row * PP + col) = pack8(v0, v1);
                }
                if (sq_cq || sq_ckv) {
                    sq += __shfl_xor(sq, 16); sq += __shfl_xor(sq, 32);
                    if (fq == 0) { if (sq_cq) ssqCQ[(size_t)row * 4 + wc] = sq; else ssqCKV[(size_t)row * 4 + wc] = sq; }
                }
                asm volatile("" ::: "memory");
            }
    }
};
template <> struct pg8::EpiSignals<EpiIn> { static constexpr bool on = true; };
template <bool ROPE> struct EpiLat {
    struct Info { float s; };
    bf16_t* O; int ldc; const float* ssq4; float invn; const float* cs;
    DI Info info_load(const pg8::Unit& u, int tid) const { return Info{tid < 256 ? sum4(ssq4 + (size_t)(u.pm * 256 + tid) * 4) : 0.f}; }
    DI void info_store(LAS float* tab, int tid, const Info& i) const { if (tid < 256) tab[tid] = 1.0f / sqrtf(i.s * invn + EPS); }
    DI void operator()(AccRef acc, const pg8::Unit& u, int wr, int wc, int fr, int fq, const LAS float* tab) const {
        const int colb = u.pn * 256 + wc * 32 + 8 * fq;
        int ro[2] = {-1, -1};
        if (ROPE) {
#pragma unroll
            for (int bj = 0; bj < 2; ++bj) ro[bj] = wuq_rope_off(colb + bj * 128);
        }
#pragma unroll
        for (int ai = 0; ai < 2; ++ai)
#pragma unroll
            for (int m = 0; m < 4; ++m) {
                const int rr = ai * 128 + wr * 64 + m * 16 + fr, row = u.pm * 256 + rr;
                const float rstd = tab[rr];
#pragma unroll
                for (int bj = 0; bj < 2; ++bj) {
                    f32x4 v0 = acc[ai][bj][m][0] * rstd, v1 = acc[ai][bj][m][1] * rstd;
                    if (ROPE && ro[bj] >= 0) {
                        const f32x4 c4 = *(const f32x4*)(cs + (size_t)row * CSW + ro[bj]), s4 = *(const f32x4*)(cs + (size_t)row * CSW + NFREQ + ro[bj]);
                        const f32x4 n0 = v0 * c4 - v1 * s4, n1 = v1 * c4 + v0 * s4; v0 = n0; v1 = n1;
                    }
                    if (ROPE) { v0 = v0 * QS_MLA; v1 = v1 * QS_MLA; }
                    *(u32x4*)(O + (size_t)row * ldc + colb + bj * 128) = pack8(v0, v1);
                }
                if (m & 1) asm volatile("" ::: "memory");
            }
    }
};
DI f32x4 bf2lo(const unsigned a, const unsigned b) { return (f32x4){__uint_as_float(a << 16), __uint_as_float(a & 0xffff0000u), __uint_as_float(b << 16), __uint_as_float(b & 0xffff0000u)}; }
struct EpiResB {
    typedef NoInfo Info;
    bf16_t* h; float* ssq16; float ascale;
    DI Info info_load(const pg8::Unit&, int) const { return Info{}; }
    DI void info_store(LAS float*, int, const Info&) const {}
    DI void operator()(AccRef acc, const pg8::Unit& u, int wr, int wc, int fr, int fq, const LAS float*) const {
        const int colb = u.pn * 256 + wc * 32 + 8 * fq;
#pragma unroll
        for (int ai = 0; ai < 2; ++ai)
#pragma unroll
            for (int m = 0; m < 4; ++m) {
                const int row = u.pm * 256 + ai * 128 + wr * 64 + m * 16 + fr;
                float sq = 0.f;
#pragma unroll
                for (int bj = 0; bj < 2; ++bj) {
                    const size_t off = (size_t)row * DM + colb + bj * 128;
                    const u32x4 hv = *(const u32x4*)(h + off);
                    const f32x4 v0 = bf2lo(hv.x, hv.y) + acc[ai][bj][m][0] * ascale, v1 = bf2lo(hv.z, hv.w) + acc[ai][bj][m][1] * ascale;
                    *(u32x4*)(h + off) = pack8(v0, v1);
                    if (ssq16) sq += dot4(v0) + dot4(v1);
                }
                if (ssq16) { sq += __shfl_xor(sq, 16); sq += __shfl_xor(sq, 32);
                    if (fq == 0) ssq16[(size_t)row * 16 + u.pn * 4 + wc] = sq; }
                if (m == 3) asm volatile("" ::: "memory");
            }
    }
};
struct EpiRes {
    typedef NoInfo Info;
    const float* hprev; float* hout; bf16_t* hb; float* ssq16; float ascale;
    DI Info info_load(const pg8::Unit&, int) const { return Info{}; }
    DI void info_store(LAS float*, int, const Info&) const {}
    DI void operator()(AccRef acc, const pg8::Unit& u, int wr, int wc, int fr, int fq, const LAS float*) const {
        const int colb = u.pn * 256 + wc * 32 + 8 * fq;
#pragma unroll
        for (int ai = 0; ai < 2; ++ai)
#pragma unroll
            for (int m = 0; m < 4; ++m) {
                const int row = u.pm * 256 + ai * 128 + wr * 64 + m * 16 + fr;
                float sq = 0.f;
#pragma unroll
                for (int bj = 0; bj < 2; ++bj) {
                    const size_t off = (size_t)row * DM + colb + bj * 128;
                    const f32x4 v0 = *(const f32x4*)(hprev + off) + acc[ai][bj][m][0] * ascale, v1 = *(const f32x4*)(hprev + off + 4) + acc[ai][bj][m][1] * ascale;
                    *(f32x4*)(hout + off) = v0; *(f32x4*)(hout + off + 4) = v1;
                    if (hb) { *(u32x4*)(hb + off) = pack8(v0, v1); sq += dot4(v0) + dot4(v1); }
                }
                if (hb) { sq += __shfl_xor(sq, 16); sq += __shfl_xor(sq, 32);
                    if (fq == 0) ssq16[(size_t)row * 16 + u.pn * 4 + wc] = sq; }
                if (m == 3) asm volatile("" ::: "memory");
            }
    }
};
DI float silu_mul(float g, float uu) { const float e = __builtin_amdgcn_exp2f(-1.4426950408889634f * g); return g * uu * __builtin_amdgcn_rcpf(1.0f + e); }
DI f32x2 silu_mul_pk(f32x2 g, f32x2 uu, float sc) { const f32x2 t = g * (-1.4426950408889634f); f32x2 e; e.x = __builtin_amdgcn_exp2f(t.x); e.y = __builtin_amdgcn_exp2f(t.y);
    const f32x2 d = e + 1.0f; f32x2 rc; rc.x = __builtin_amdgcn_rcpf(d.x); rc.y = __builtin_amdgcn_rcpf(d.y); return (g * rc) * (uu * sc); }
DI unsigned pk4_fp8(float a, float b, float c, float d) {
    a = __builtin_amdgcn_fmed3f(a, -448.f, 448.f); b = __builtin_amdgcn_fmed3f(b, -448.f, 448.f); c = __builtin_amdgcn_fmed3f(c, -448.f, 448.f); d = __builtin_amdgcn_fmed3f(d, -448.f, 448.f);
    int w = 0; w = __builtin_amdgcn_cvt_pk_fp8_f32(a, b, w, false); w = __builtin_amdgcn_cvt_pk_fp8_f32(c, d, w, true); return (unsigned)w; }
typedef const i32x4 (&AccRefI)[2][2][4][2];
template <bool MOE> struct EpiGU8 {
    struct Info { float r; };
    unsigned char* act; const float* ra; const float* sb; const int* rowtok; const LAS int* tile_e;
    DI Info info_load(const pg8::Unit& u, int tid) const { float r = 0.f; if (tid < 256) { int t = u.pm * 256 + tid; if (MOE) { t = rowtok[t]; t = t < 0 ? 0 : t; } r = ra[t]; } return Info{r}; }
    DI void info_store(LAS float* tab, int tid, const Info& i) const { if (tid < 256) tab[tid] = i.r; }
    DI void operator()(AccRefI acc, const pg8::Unit& u, int wr, int wc, int fr, int fq, const LAS float* tab) const {
        const int colb = u.pn * 128 + wc * 32 + 8 * fq;
        const float* sbp = sb + (MOE ? (size_t)(tile_e[u.pm] & 7) * (2 * DFF) : 0) + u.pn * 256 + wc * 32 + 8 * fq;
        const f32x4 sg0 = *(const f32x4*)sbp, sg1 = *(const f32x4*)(sbp + 4), su0 = *(const f32x4*)(sbp + 128), su1 = *(const f32x4*)(sbp + 132);
#pragma unroll
        for (int ai = 0; ai < 2; ++ai)
#pragma unroll
            for (int m = 0; m < 4; ++m) {
                const int rr = ai * 128 + wr * 64 + m * 16 + fr, row = u.pm * 256 + rr;
                const float r = tab[rr];
                const f32x4 g0 = __builtin_convertvector(acc[ai][0][m][0], f32x4) * sg0 * r, g1 = __builtin_convertvector(acc[ai][0][m][1], f32x4) * sg1 * r;
                const f32x4 u0 = __builtin_convertvector(acc[ai][1][m][0], f32x4) * su0, u1 = __builtin_convertvector(acc[ai][1][m][1], f32x4) * su1;
                const float rs = r * ACT_SCALE;
                const f32x2 a01 = silu_mul_pk((f32x2){g0[0], g0[1]}, (f32x2){u0[0], u0[1]}, rs), a23 = silu_mul_pk((f32x2){g0[2], g0[3]}, (f32x2){u0[2], u0[3]}, rs);
                const f32x2 a45 = silu_mul_pk((f32x2){g1[0], g1[1]}, (f32x2){u1[0], u1[1]}, rs), a67 = silu_mul_pk((f32x2){g1[2], g1[3]}, (f32x2){u1[2], u1[3]}, rs);
                u32x2 w; w.x = pk4_fp8(a01.x, a01.y, a23.x, a23.y); w.y = pk4_fp8(a45.x, a45.y, a67.x, a67.y);
                *(u32x2*)(act + (size_t)row * DFF + colb) = w;
            }
    }
};
struct EpiDownMoe {
    struct Info { int t; float g; };
    bf16_t* hout; bf16_t* y2; const int* rowtok; const float* rowgate; const LAS int* tile_e; float ascale;
    DI Info info_load(const pg8::Unit& u, int tid) const { Info i{-1, 0.f}; if (tid < 256) { i.t = rowtok[u.pm * 256 + tid]; i.g = rowgate[u.pm * 256 + tid]; } return i; }
    DI void info_store(LAS float* tab, int tid, const Info& i) const { if (tid < 256) { tab[tid] = __int_as_float(i.t); tab[256 + tid] = i.g * ascale; } }
    DI void operator()(AccRef acc, const pg8::Unit& u, int wr, int wc, int fr, int fq, const LAS float* tab) const {
        const int colb = u.pn * 256 + wc * 32 + 8 * fq; const bool second = tile_e[u.pm] >= 8;
#pragma unroll
        for (int ai = 0; ai < 2; ++ai)
#pragma unroll
            for (int m = 0; m < 4; ++m) {
                const int rr = ai * 128 + wr * 64 + m * 16 + fr;
                const int t = __float_as_int(tab[rr]); const float gt = tab[256 + rr];
                if (t >= 0) {
#pragma unroll
                    for (int bj = 0; bj < 2; ++bj) {
                        const size_t off = (size_t)t * DM + colb + bj * 128;
                        f32x4 v0 = acc[ai][bj][m][0] * gt, v1 = acc[ai][bj][m][1] * gt;
                        if (second) { if (ascale != 0.f) *(u32x4*)(y2 + off) = pack8(v0, v1); }
                        else { const u32x4 hv = *(const u32x4*)(hout + off); v0 += bf2lo(hv.x, hv.y); v1 += bf2lo(hv.z, hv.w); *(u32x4*)(hout + off) = pack8(v0, v1); }
                    }
                }
                if (m == 3) asm volatile("" ::: "memory");
            }
    }
};

#define MFMA32(a, b, c) __builtin_amdgcn_mfma_f32_32x32x16_bf16((a), (b), (c), 0, 0, 0)
DI int crow(int r, int hi) { return (r & 3) + 8 * (r >> 2) + 4 * hi; }
DI float max3f(float a, float b, float c) { float r; asm("v_max3_f32 %0, %1, %2, %3" : "=v"(r) : "v"(a), "v"(b), "v"(c)); return r; }
DI float max2f(float a, float b) { float r; asm("v_max_f32_e32 %0, %1, %2" : "=v"(r) : "v"(a), "v"(b)); return r; }
DI unsigned bfi32(unsigned m, unsigned a, unsigned b) { unsigned r; asm("v_bfi_b32 %0, %1, %2, %3" : "=v"(r) : "v"(m), "v"(a), "v"(b)); return r; }
DI float hswap_max(float m) { auto rr = __builtin_amdgcn_permlane32_swap(__float_as_uint(m), __float_as_uint(m), false, false); return fmaxf(__uint_as_float(rr[0]), __uint_as_float(rr[1])); }
DI float hswap_sum(float m) { auto rr = __builtin_amdgcn_permlane32_swap(__float_as_uint(m), __float_as_uint(m), false, false); return __uint_as_float(rr[0]) + __uint_as_float(rr[1]); }
DI s16x4 vtr(const LAS unsigned char* p) { return __builtin_bit_cast(s16x4, __builtin_amdgcn_ds_read_tr16_b64_v4i16((LAS s16x4*)p)); }

template <int TYPE>
DI void attn_unit(LAS unsigned char* lds, const bf16_t* __restrict__ P, const bf16_t* __restrict__ QC, const bf16_t* __restrict__ KV, const unsigned* __restrict__ MASK, bf16_t* __restrict__ O,
                  const int b, const int h, const int qb, const float* __restrict__ subln, const float lam, const float outscale) {
    constexpr int KD = (TYPE == 0) ? 96 : 64;
    constexpr int DPM = (TYPE == 1) ? 32 : KD;
    constexpr int KST = DPM / 16;
    constexpr int KP = KD * 2 + 16;
    constexpr int NKC = KD / 8;
    constexpr int KBYTES = 64 * KP, BUFSZ = KBYTES + 8192, OST = 2 * BUFSZ, XCH = OST + 8 * (32 * 144);
    int tid_ = threadIdx.x; asm volatile("" : "+v"(tid_));
    const int tid = tid_, lane = tid & 63, r32 = lane & 31, hi = lane >> 5; const int w = __builtin_amdgcn_readfirstlane(tid >> 6);
    const int rowb = b * SEQ;
    int qrow, head, ntiles, wtiles, dimoff = 0;
    if (TYPE == 2) { qrow = rowb + 64 * qb + 32 * (w & 1) + r32; head = w >> 1; ntiles = qb + 1; wtiles = qb + 1; }
    else if (TYPE == 1) { qrow = rowb + 128 * qb + 32 * (w & 3) + r32; head = h; ntiles = 2 * qb + 2; wtiles = 2 * qb + ((w & 3) >> 1) + 1; dimoff = 32 * (w >> 2); }
    else { qrow = rowb + 256 * qb + 32 * w + r32; head = h; ntiles = 4 * qb + 4; wtiles = 4 * qb + (w >> 1) + 1; }
    bf16x8 qf[KST];
    {
        const bf16_t* qp = (TYPE == 0) ? QC + (size_t)qrow * 768 + head * 96 : (TYPE == 1) ? P + (size_t)qrow * PP + TQB + head * 64 + dimoff : P + (size_t)qrow * PP + TQA + head * 64;
#pragma unroll
        for (int ks = 0; ks < KST; ++ks) qf[ks] = *(const bf16x8*)(qp + 16 * ks + 8 * hi);
    }
    const int kkey0 = tid / NKC, kck0 = tid % NKC, kkey1 = (tid + 512) / NKC, kck1 = (tid + 512) % NKC;
    const bool k2nd = (TYPE == 0) && (tid < 256);
    const int vcl = tid & 3, vkey = (tid >> 2) & 63, vd0 = tid >> 8;
    auto ksrc = [&](int j, int key, int ck) -> const bf16_t* {
        const size_t kr = (size_t)(rowb + 64 * j + key);
        if (TYPE == 0) return ck < 8 ? KV + kr * 1024 + head * 128 + 8 * ck : P + kr * PP + TKR + 8 * (ck - 8);
        if (TYPE == 1) return P + kr * PP + TKB + head * 64 + 8 * ck;
        return P + kr * PP + TKA + 8 * ck;
    };
    auto vsrc = [&](int j) -> const bf16_t* {
        const size_t kr = (size_t)(rowb + 64 * j + vkey); const int d = 32 * vd0 + 8 * vcl;
        if (TYPE == 0) return KV + kr * 1024 + head * 128 + 64 + d;
        if (TYPE == 1) return P + kr * PP + TVB + head * 64 + d;
        return P + kr * PP + TVA + d;
    };
    u32x4 sk0, sk1 = (u32x4){0u, 0u, 0u, 0u}, sv;
#define ATT_LOAD(j) do { sk0 = *(const u32x4*)ksrc((j), kkey0, kck0); if (k2nd) sk1 = *(const u32x4*)ksrc((j), kkey1, kck1); sv = *(const u32x4*)vsrc(j); } while (0)
#define ATT_STORE(buf) do { LAS unsigned char* kb_ = lds + (buf) * BUFSZ; *(LAS u32x4*)(kb_ + kkey0 * KP + kck0 * 16) = sk0; if (k2nd) *(LAS u32x4*)(kb_ + kkey1 * KP + kck1 * 16) = sk1; \
        *(LAS u32x4*)(kb_ + KBYTES + tid * 16) = sv; } while (0)
    f32x2 lrA = (f32x2){0.f, 0.f}, lrB = (f32x2){0.f, 0.f}; f32x16 o[2], negm;
#pragma unroll
    for (int r = 0; r < 16; ++r) { negm[r] = 0.f; o[0][r] = 0.f; o[1][r] = 0.f; }
    ATT_LOAD(0); ATT_STORE(0);
    if (ntiles > 1) ATT_LOAD(1);
    asm volatile("s_waitcnt lgkmcnt(0)\n\ts_barrier" ::: "memory");
    const int voff = ((lane >> 4) & 1) * 32 + (lane & 3) * 8 + (4 * hi + ((lane & 15) >> 2)) * 64;
    u32x2 mwn = (u32x2){0xffffffffu, 0xffffffffu};
    const bool allsel = (TYPE == 2) && (qb < 4);
    if (TYPE == 2 && !allsel) mwn = *(const u32x2*)(MASK + (size_t)qrow * 64);
    for (int j = 0; j < ntiles; ++j) {
        const LAS unsigned char* Kb = lds + (j & 1) * BUFSZ; const LAS unsigned char* Vb = Kb + KBYTES;
        if (j < wtiles) {
            unsigned mw0 = 0xffffffffu, mw1 = 0xffffffffu;
            if (TYPE == 2) { mw0 = mwn.x >> (4 * hi); mw1 = mwn.y >> (4 * hi); if (!allsel && j + 1 < wtiles) mwn = *(const u32x2*)(MASK + (size_t)qrow * 64 + 2 * (j + 1)); }
            auto qk = [&](f32x16& s0, f32x16& s1) {
                const bf16x8 k0 = *(const LAS bf16x8*)(Kb + r32 * KP + (dimoff + 8 * hi) * 2);
                const bf16x8 k1 = *(const LAS bf16x8*)(Kb + (32 + r32) * KP + (dimoff + 8 * hi) * 2);
                if (TYPE == 2) {
                    f32x16 c0, c1; const unsigned nb = __float_as_uint(negm[0]), ninf = 0xff800000u;
#pragma unroll
                    for (int r = 0; r < 16; ++r) { const unsigned pos = (r & 3) + 8 * (r >> 2);
                        const unsigned t0 = (unsigned)__builtin_amdgcn_sbfe((int)mw0, pos, 1u), t1 = (unsigned)__builtin_amdgcn_sbfe((int)mw1, pos, 1u);
                        c0[r] = __uint_as_float(bfi32(t0, nb, ninf)); c1[r] = __uint_as_float(bfi32(t1, nb, ninf)); }
                    s0 = MFMA32(k0, qf[0], c0); s1 = MFMA32(k1, qf[0], c1);
                } else {
                    asm("v_mfma_f32_32x32x16_bf16 %0, %1, %2, %3" : "=&v"(s0) : "v"(k0), "v"(qf[0]), "v"(negm));
                    asm("v_mfma_f32_32x32x16_bf16 %0, %1, %2, %3" : "=&v"(s1) : "v"(k1), "v"(qf[0]), "v"(negm));
                }
#pragma unroll
                for (int ks = 1; ks < KST; ++ks) {
                    const bf16x8 ka = *(const LAS bf16x8*)(Kb + r32 * KP + (dimoff + 16 * ks + 8 * hi) * 2);
                    const bf16x8 kb = *(const LAS bf16x8*)(Kb + (32 + r32) * KP + (dimoff + 16 * ks + 8 * hi) * 2);
                    s0 = MFMA32(ka, qf[ks], s0); s1 = MFMA32(kb, qf[ks], s1);
                }
            };
            f32x16 s0, s1; qk(s0, s1);
            float r0, r1, r2, r3;
#pragma unroll
            for (int r = 0; r < 16; r += 2) {
                s0[r] = __builtin_amdgcn_exp2f(s0[r]); s0[r + 1] = __builtin_amdgcn_exp2f(s0[r + 1]); s1[r] = __builtin_amdgcn_exp2f(s1[r]); s1[r + 1] = __builtin_amdgcn_exp2f(s1[r + 1]);
                if (r == 2) asm("s_nop 0\n\tv_add_f32_e32 %0, %4, %8\n\tv_add_f32_e32 %1, %5, %9\n\tv_add_f32_e32 %2, %6, %10\n\tv_add_f32_e32 %3, %7, %11"
                                : "=&v"(r0), "=&v"(r1), "=&v"(r2), "=&v"(r3) : "v"(s0[0]), "v"(s0[1]), "v"(s1[0]), "v"(s1[1]), "v"(s0[2]), "v"(s0[3]), "v"(s1[2]), "v"(s1[3]));
                if (r > 2) asm("s_nop 0\n\tv_add_f32_e32 %0, %4, %0\n\tv_add_f32_e32 %1, %5, %1\n\tv_add_f32_e32 %2, %6, %2\n\tv_add_f32_e32 %3, %7, %3"
                               : "+v"(r0), "+v"(r1), "+v"(r2), "+v"(r3) : "v"(s0[r]), "v"(s0[r + 1]), "v"(s1[r]), "v"(s1[r + 1]));
            }
            if (__any(!(max2f(max3f(r0, r1, r2), r3) <= 65536.0f))) {
                qk(s0, s1);
                asm volatile("s_nop 11" : "+v"(s0), "+v"(s1));
                float mxa = max3f(s0[0], s0[1], s1[0]), mxb = max3f(s0[2], s0[3], s1[1]); mxa = max3f(mxa, s1[2], s1[3]);
#pragma unroll
                for (int r = 4; r < 16; r += 4) { mxa = max3f(mxa, s0[r], s0[r + 1]); mxb = max3f(mxb, s0[r + 2], s0[r + 3]); mxa = max3f(mxa, s1[r], s1[r + 1]); mxb = max3f(mxb, s1[r + 2], s1[r + 3]); }
                float mx = max2f(mxa, mxb);
                { auto rr = __builtin_amdgcn_permlane32_swap(__float_as_uint(mx), __float_as_uint(mx), false, false); mx = max2f(__uint_as_float(rr[0]), __uint_as_float(rr[1])); }
                const unsigned dlb = __float_as_uint(fmaxf(mx, 0.f)) & 0xffff0000u;
                const float dl = __uint_as_float(dlb), f = __builtin_amdgcn_exp2f(-dl);
                lrA *= f; lrB *= f;
                const unsigned sel = hi ? 0u : 0xffffffffu;
                const u32x4 aw = (u32x4){0x3f80u & sel, 0u, 0u, 0u}, bw = (u32x4){((dlb >> 16) | 0x8000u) & sel, 0u, 0u, 0u};
                negm = MFMA32(__builtin_bit_cast(bf16x8, aw), __builtin_bit_cast(bf16x8, bw), negm);
                float q0 = 0.f, q1 = 0.f, q2 = 0.f, q3 = 0.f;
#pragma unroll
                for (int r = 0; r < 16; r += 2) {
                    o[0][r] *= f; o[0][r + 1] *= f; o[1][r] *= f; o[1][r + 1] *= f;
                    s0[r] = __builtin_amdgcn_exp2f(s0[r] - dl); s0[r + 1] = __builtin_amdgcn_exp2f(s0[r + 1] - dl); s1[r] = __builtin_amdgcn_exp2f(s1[r] - dl); s1[r + 1] = __builtin_amdgcn_exp2f(s1[r + 1] - dl);
                    q0 += s0[r]; q1 += s0[r + 1]; q2 += s1[r]; q3 += s1[r + 1];
                }
                r0 = q0; r1 = q1; r2 = q2; r3 = q3;
            }
            lrA[0] += r0; lrA[1] += r1; lrB[0] += r2; lrB[1] += r3;
#pragma unroll
            for (int ks4 = 0; ks4 < 4; ++ks4) {
                u32x4 pw;
                if (ks4 == 0)      { pw.x = pk2(s0[0], s0[1]);  pw.y = pk2(s0[2], s0[3]);   pw.z = pk2(s0[4], s0[5]);   pw.w = pk2(s0[6], s0[7]); }
                else if (ks4 == 1) { pw.x = pk2(s0[8], s0[9]);  pw.y = pk2(s0[10], s0[11]); pw.z = pk2(s0[12], s0[13]); pw.w = pk2(s0[14], s0[15]); }
                else if (ks4 == 2) { pw.x = pk2(s1[0], s1[1]);  pw.y = pk2(s1[2], s1[3]);   pw.z = pk2(s1[4], s1[5]);   pw.w = pk2(s1[6], s1[7]); }
                else               { pw.x = pk2(s1[8], s1[9]);  pw.y = pk2(s1[10], s1[11]); pw.z = pk2(s1[12], s1[13]); pw.w = pk2(s1[14], s1[15]); }
                const bf16x8 pb = __builtin_bit_cast(bf16x8, pw);
#pragma unroll
                for (int d0 = 0; d0 < 2; ++d0) {
                    const s16x4 lo = vtr(Vb + voff + d0 * 4096 + ks4 * 1024), hh = vtr(Vb + voff + d0 * 4096 + ks4 * 1024 + 512);
                    const bf16x8 vf = (bf16x8){lo[0], lo[1], lo[2], lo[3], hh[0], hh[1], hh[2], hh[3]};
                    o[d0] = MFMA32(vf, pb, o[d0]);
                }
            }
        }
        if (j + 1 < ntiles) { ATT_STORE((j + 1) & 1); if (j + 2 < ntiles) ATT_LOAD(j + 2); }
        asm volatile("s_waitcnt lgkmcnt(0)\n\ts_barrier" ::: "memory");
    }
#undef ATT_LOAD
#undef ATT_STORE
    float res[2][16];
    {
        const float i0 = ((TYPE == 1 && w >= 4) ? lam : 1.0f) / hswap_sum((lrA[0] + lrA[1]) + (lrB[0] + lrB[1]));
#pragma unroll
        for (int d0 = 0; d0 < 2; ++d0)
#pragma unroll
            for (int r = 0; r < 16; ++r) res[d0][r] = o[d0][r] * i0;
    }
    if (TYPE == 1) {
        LAS float* xch = (LAS float*)(lds + XCH) + (w & 3) * 2048;
        if (w >= 4) {
#pragma unroll
            for (int d0 = 0; d0 < 2; ++d0)
#pragma unroll
                for (int r = 0; r < 16; ++r) xch[(d0 * 16 + r) * 64 + lane] = res[d0][r];
        }
        __syncthreads();
        if (w < 4) {
            float sq = 0.f;
#pragma unroll
            for (int d0 = 0; d0 < 2; ++d0)
#pragma unroll
                for (int r = 0; r < 16; ++r) { const float v = res[d0][r] - xch[(d0 * 16 + r) * 64 + lane]; res[d0][r] = v; sq += v * v; }
            sq = hswap_sum(sq);
            const float rstd = outscale / sqrtf(sq * (1.0f / 64.0f) + EPS);
#pragma unroll
            for (int d0 = 0; d0 < 2; ++d0)
#pragma unroll
                for (int r = 0; r < 16; ++r) res[d0][r] *= rstd * subln[32 * d0 + crow(r, hi)];
        }
    }
    if (TYPE != 1 || w < 4) {
        LAS unsigned char* stg = lds + OST + w * (32 * 144);
#pragma unroll
        for (int d0 = 0; d0 < 2; ++d0)
#pragma unroll
            for (int r = 0; r < 16; r += 2) *(LAS unsigned*)(stg + r32 * 144 + (32 * d0 + crow(r, hi)) * 2) = pk2(res[d0][r], res[d0][r + 1]);
        asm volatile("s_waitcnt lgkmcnt(0)" ::: "memory");
        const int ocol = (TYPE == 0) ? 512 + head * 64 : (TYPE == 1) ? 256 + head * 64 : head * 64;
        const int orow0 = qrow - r32;
#pragma unroll
        for (int i = 0; i < 4; ++i) { const int row = i * 8 + (lane >> 3), ch = lane & 7;
            const u32x4 v = *(const LAS u32x4*)(stg + row * 144 + ch * 16);
            *(u32x4*)(O + (size_t)(orow0 + row) * DM + ocol + ch * 8) = v; }
    }
    __syncthreads();
}

#define MFMA16(a, b, c) __builtin_amdgcn_mfma_f32_16x16x32_bf16((a), (b), (c), 0, 0, 0)
DI unsigned f2ord(float f) { const unsigned u = __float_as_uint(f); return (u & 0x80000000u) ? ~u : (u | 0x80000000u); }
DI float ord2f(unsigned u) { return __uint_as_float((u & 0x80000000u) ? (u & 0x7fffffffu) : ~u); }
constexpr int IDX_TOPK = 256;
DI void cnt4(unsigned& cnt, const f32x4 e, const float mid) {
    unsigned long long m0, m1, m2;
    asm("v_cmp_ge_f32_e64 %1, %4, %8\n\t"
        "v_cmp_ge_f32_e64 %2, %5, %8\n\t"
        "v_cmp_ge_f32_e64 %3, %6, %8\n\t"
        "v_cmp_ge_f32_e32 vcc, %7, %8\n\t"
        "v_addc_co_u32_e64 %0, %1, 0, %0, %1\n\t"
        "v_addc_co_u32_e64 %0, %2, 0, %0, %2\n\t"
        "v_addc_co_u32_e64 %0, %3, 0, %0, %3\n\t"
        "v_addc_co_u32_e32 %0, vcc, 0, %0, vcc"
        : "+v"(cnt), "=&s"(m0), "=&s"(m1), "=&s"(m2) : "v"(e[0]), "v"(e[1]), "v"(e[2]), "v"(e[3]), "v"(mid) : "vcc");
}
DI void idx_unit(LAS unsigned char* lds, const bf16_t* __restrict__ P, unsigned* __restrict__ MASK, const int b, const int g16) {
    int tid_ = threadIdx.x; asm volatile("" : "+v"(tid_));
    const int tid = tid_, lane = tid & 63, q = lane & 15, g = lane >> 4; const int w = __builtin_amdgcn_readfirstlane(tid >> 6);
    const int c = g16 >> 2, NT = 4 * (c + 1);
    const int row0 = b * SEQ + 16 * g16;
    if (c < 4) {
        for (int i = tid; i < 16 * 64; i += 512) { const int qq = i >> 6, wd = i & 63; MASK[(size_t)(row0 + qq) * 64 + wd] = (wd < 2 * (c + 1)) ? 0xffffffffu : 0u; }
        return;
    }
    constexpr int IDXM = 0;
    LAS unsigned short* lmask = (LAS unsigned short*)(lds + IDXM);
    LAS unsigned short* leq = (LAS unsigned short*)(lds + IDXM + 4096);
    LAS float* redf = (LAS float*)(lds + IDXM + 8192);
    LAS unsigned* cbuf = (LAS unsigned*)(lds + IDXM + 8192 + 1024);
    LAS int* needs = (LAS int*)(lds + IDXM + 8192 + 2048);
    LAS unsigned* ccnt = (LAS unsigned*)(lds + IDXM + 8192 + 3072 + 2048);
    if (tid < 16) ccnt[tid] = 0u;
    for (int i = tid; i < 2048; i += 512) ((LAS unsigned*)(lds + IDXM))[i] = 0u;
    bf16x8 qf[8][2]; float wq[8];
    {
        const bf16_t* qp = P + (size_t)(row0 + q) * PP;
#pragma unroll
        for (int hd = 0; hd < 8; ++hd)
#pragma unroll
            for (int ks = 0; ks < 2; ++ks) qf[hd][ks] = *(const bf16x8*)(qp + TQI + hd * 64 + 32 * ks + 8 * g);
        const u32x4 wv = *(const u32x4*)(qp + TWI);
#pragma unroll
        for (int i = 0; i < 4; ++i) { wq[2 * i] = __uint_as_float(wv[i] << 16); wq[2 * i + 1] = __uint_as_float(wv[i] & 0xffff0000u); }
    }
    f32x4 sc[16];
    float vmin = INFINITY, vmax = -INFINITY, sm1 = 0.f, sm2 = 0.f;
    const int ntw = (NT - w + 7) >> 3;
    const bf16_t* kbase = P + (size_t)(b * SEQ + q) * PP + TKI + 8 * g;
    bf16x8 kA0, kA1, kB0, kB1;
    kA0 = *(const bf16x8*)(kbase + (size_t)(16 * w) * PP); kA1 = *(const bf16x8*)(kbase + (size_t)(16 * w) * PP + 32);
    kB0 = kA0; kB1 = kA1;
    if (ntw > 1) { kB0 = *(const bf16x8*)(kbase + (size_t)(16 * (w + 8)) * PP); kB1 = *(const bf16x8*)(kbase + (size_t)(16 * (w + 8)) * PP + 32); }
#pragma unroll
    for (int i = 0; i < 16; ++i) {
        if (i < ntw) {
            const bf16x8 k0 = kA0, k1 = kA1;
            kA0 = kB0; kA1 = kB1;
            if (i + 2 < ntw) { const bf16_t* kp_ = kbase + (size_t)(16 * (w + 8 * (i + 2))) * PP; kB0 = *(const bf16x8*)kp_; kB1 = *(const bf16x8*)(kp_ + 32); }
            f32x4 s = (f32x4){0.f, 0.f, 0.f, 0.f};
            f32x4 ah[8];
#pragma unroll
            for (int hd = 0; hd < 8; ++hd) { ah[hd] = (f32x4){0.f, 0.f, 0.f, 0.f}; ah[hd] = MFMA16(k0, qf[hd][0], ah[hd]); ah[hd] = MFMA16(k1, qf[hd][1], ah[hd]); }
            asm volatile("s_nop 15" : "+v"(ah[0]), "+v"(ah[1]), "+v"(ah[2]), "+v"(ah[3]), "+v"(ah[4]), "+v"(ah[5]), "+v"(ah[6]), "+v"(ah[7]));
#pragma unroll
            for (int hd = 0; hd < 8; ++hd) {
#pragma unroll
                for (int r = 0; r < 4; ++r) { float rl; asm("v_max_f32_e32 %0, 0, %1" : "=v"(rl) : "v"(ah[hd][r])); s[r] = __builtin_fmaf(wq[hd], rl, s[r]); }
            }
#pragma unroll
            for (int r = 0; r < 4; ++r) { s[r] += 0.0f; vmin = fminf(vmin, s[r]); vmax = fmaxf(vmax, s[r]); sm1 += s[r]; sm2 = __builtin_fmaf(s[r], s[r], sm2); }
            sc[i] = s;
        } else sc[i] = (f32x4){-INFINITY, -INFINITY, -INFINITY, -INFINITY};
    }
    vmin = fminf(vmin, __shfl_xor(vmin, 16)); vmin = fminf(vmin, __shfl_xor(vmin, 32));
    vmax = fmaxf(vmax, __shfl_xor(vmax, 16)); vmax = fmaxf(vmax, __shfl_xor(vmax, 32));
    sm1 += __shfl_xor(sm1, 16); sm1 += __shfl_xor(sm1, 32); sm2 += __shfl_xor(sm2, 16); sm2 += __shfl_xor(sm2, 32);
    LAS float* msum = (LAS float*)(lds + IDXM + 8192 + 3072 + 2048 + 64 + 256);
    if (g == 0) { redf[q * 8 + w] = vmin; redf[128 + q * 8 + w] = vmax; msum[q * 8 + w] = sm1; msum[128 + q * 8 + w] = sm2; }
    __syncthreads();
    float lo, hiT;
    { const f32x4 a = *(const LAS f32x4*)(redf + q * 8), bb = *(const LAS f32x4*)(redf + q * 8 + 4); lo = fminf(fminf(fminf(a[0], a[1]), fminf(a[2], a[3])), fminf(fminf(bb[0], bb[1]), fminf(bb[2], bb[3])));
      const f32x4 c2 = *(const LAS f32x4*)(redf + 128 + q * 8), d2 = *(const LAS f32x4*)(redf + 128 + q * 8 + 4); hiT = fmaxf(fmaxf(fmaxf(c2[0], c2[1]), fmaxf(c2[2], c2[3])), fmaxf(fmaxf(d2[0], d2[1]), fmaxf(d2[2], d2[3]))); }
    float g0, gslope;
    { const f32x4 a = *(const LAS f32x4*)(msum + q * 8), bb = *(const LAS f32x4*)(msum + q * 8 + 4), c2 = *(const LAS f32x4*)(msum + 128 + q * 8), d2 = *(const LAS f32x4*)(msum + 128 + q * 8 + 4);
      const float S1 = ((a[0] + a[1]) + (a[2] + a[3])) + ((bb[0] + bb[1]) + (bb[2] + bb[3])), S2 = ((c2[0] + c2[1]) + (c2[2] + c2[3])) + ((d2[0] + d2[1]) + (d2[2] + d2[3]));
      const float nf = (float)(16 * NT), mu = S1 / nf, sd = sqrtf(fmaxf(S2 / nf - mu * mu, 0.f)), p = (float)IDX_TOPK / nf;
      const float z = 4.91f * (__builtin_amdgcn_exp2f(0.14f * __builtin_amdgcn_logf(1.0f - p)) - __builtin_amdgcn_exp2f(0.14f * __builtin_amdgcn_logf(p)));
      g0 = mu + z * sd; gslope = nf * __builtin_amdgcn_exp2f(-0.7213475f * z * z) * 0.3989423f / sd; }
    float pmid = 0.f, pstep = 0.f; unsigned pcnt = 0u; bool lop = false, hip = false;
    hiT = ord2f(f2ord(hiT) + 1u);
    bool done = false; float tge = INFINITY, veq = 0.f; int need = 0; unsigned chi = 0, clo = 16u * (unsigned)NT;
    for (int it = 0; it < 80; ++it) {
        float mid;
        if (it < 24) mid = 0.5f * (lo + hiT);
        else { const unsigned ul = f2ord(lo), uh = f2ord(hiT); mid = ord2f(ul + ((uh - ul) >> 1)); }
        if (!(lop && hip)) {
            const float gm = (it == 0) ? g0 : (it == 1) ? pmid + 2.0f * ((float)pcnt - (float)IDX_TOPK + ((pcnt > (unsigned)IDX_TOPK) ? 6.f : -6.f)) / gslope : pmid + 2.0f * pstep;
            if (gm > lo && gm < hiT) mid = gm; }
        pstep = mid - pmid;
        unsigned cnt = 0;
#pragma unroll
        for (int g4 = 0; g4 < 4; ++g4) {
            if (4 * g4 < ntw) { cnt4(cnt, sc[4 * g4], mid); cnt4(cnt, sc[4 * g4 + 1], mid); cnt4(cnt, sc[4 * g4 + 2], mid); cnt4(cnt, sc[4 * g4 + 3], mid); }
        }
        LAS unsigned char* cb = (LAS unsigned char*)cbuf + (it & 1) * 512;
        cb[q * 32 + w * 4 + g] = (unsigned char)cnt;
        __syncthreads();
        { const u32x4 a = *(const LAS u32x4*)(cb + q * 32), bb = *(const LAS u32x4*)(cb + q * 32 + 16);
          unsigned s_ = 0u;
          s_ = __builtin_amdgcn_sad_u8(a[0], 0u, s_); s_ = __builtin_amdgcn_sad_u8(a[1], 0u, s_); s_ = __builtin_amdgcn_sad_u8(a[2], 0u, s_); s_ = __builtin_amdgcn_sad_u8(a[3], 0u, s_);
          s_ = __builtin_amdgcn_sad_u8(bb[0], 0u, s_); s_ = __builtin_amdgcn_sad_u8(bb[1], 0u, s_); s_ = __builtin_amdgcn_sad_u8(bb[2], 0u, s_); s_ = __builtin_amdgcn_sad_u8(bb[3], 0u, s_);
          cnt = s_; }
        pmid = mid; pcnt = cnt;
        if (!done) {
            if (cnt == (unsigned)IDX_TOPK) { tge = mid; need = 0; done = true; }
            else if (cnt > (unsigned)IDX_TOPK) { lo = mid; clo = cnt; lop = true; }
            else { hiT = mid; chi = cnt; hip = true; }
            if (!done) {
                bool coll;
                if (it + 1 < 24) { const float m2 = 0.5f * (lo + hiT); coll = !(m2 > lo && m2 < hiT); }
                else coll = (f2ord(hiT) - f2ord(lo)) <= 1u;
                if (coll) { tge = hiT; veq = lo; need = IDX_TOPK - (int)chi; done = true; }
            }
        }
        if (__all(done || (clo - chi) <= 32u)) break;
    }
    if (!__all(done)) {
        LAS float* cand = (LAS float*)(lds + IDXM + 8192 + 3072);
        LAS float* cres = (LAS float*)(lds + IDXM + 8192 + 3072 + 2048 + 64);
        if (!done) {
#pragma unroll
            for (int g4 = 0; g4 < 4; ++g4) {
                if (4 * g4 < ntw) {
#pragma unroll
                    for (int i = 4 * g4; i < 4 * g4 + 4; ++i)
#pragma unroll
                        for (int r = 0; r < 4; ++r) { const float x = sc[i][r];
                            if (x >= lo && x < hiT) { const unsigned idx = __hip_atomic_fetch_add(ccnt + q, 1u, __ATOMIC_RELAXED, __HIP_MEMORY_SCOPE_WORKGROUP); if (idx < 32u) cand[q * 32 + idx] = x; } }
                }
            }
        }
        __syncthreads();
        const unsigned rnk = (unsigned)IDX_TOPK - chi;
        if (!done) {
            const unsigned k = ccnt[q]; const unsigned j = (unsigned)(w * 4 + g);
            if (j < k) {
                const float xj = cand[q * 32 + j]; unsigned cgt = 0, ceq = 0;
#pragma unroll
                for (int i4 = 0; i4 < 8; ++i4) { const f32x4 c4 = *(const LAS f32x4*)(cand + q * 32 + 4 * i4);
#pragma unroll
                    for (int e = 0; e < 4; ++e) { const bool in = (unsigned)(4 * i4 + e) < k; cgt += (in && c4[e] > xj) ? 1u : 0u; ceq += (in && c4[e] == xj) ? 1u : 0u; } }
                if (cgt < rnk && rnk <= cgt + ceq) { cres[q * 4] = xj; cres[q * 4 + 1] = __uint_as_float(cgt); cres[q * 4 + 2] = __uint_as_float(ceq); }
            }
        }
        __syncthreads();
        if (!done) {
            const float T = cres[q * 4]; const unsigned cgt = __float_as_uint(cres[q * 4 + 1]), ceq = __float_as_uint(cres[q * 4 + 2]);
            if (cgt + ceq == rnk) { tge = T; need = 0; }
            else { tge = ord2f(f2ord(T) + 1u); veq = T; need = (int)(rnk - cgt); }
            done = true;
        }
    }
#pragma unroll
    for (int i = 0; i < 16; ++i) {
        const int t = w + 8 * i;
        unsigned ge = 0, eq = 0;
#pragma unroll
        for (int r = 0; r < 4; ++r) { ge |= (sc[i][r] >= tge) ? (1u << r) : 0u; eq |= (need > 0 && sc[i][r] == veq) ? (1u << r) : 0u; }
        if (t < NT) { const int sh = 16 * (t & 1) + 4 * g;
            if (ge) __hip_atomic_fetch_or((LAS unsigned*)lmask + q * 64 + (t >> 1), ge << sh, __ATOMIC_RELAXED, __HIP_MEMORY_SCOPE_WORKGROUP);
            if (eq) __hip_atomic_fetch_or((LAS unsigned*)leq + q * 64 + (t >> 1), eq << sh, __ATOMIC_RELAXED, __HIP_MEMORY_SCOPE_WORKGROUP); }
    }
    if (w == 0 && g == 0) needs[q] = need;
    __syncthreads();
    if (tid < 16) {
        int nd = needs[tid];
        if (nd > 0) {
            LAS unsigned* lm = (LAS unsigned*)lmask + tid * 64; const LAS unsigned* le = (const LAS unsigned*)leq + tid * 64;
            for (int wd = 0; wd < 64 && nd > 0; ++wd) {
                unsigned e = le[wd]; unsigned add = 0;
                while (e != 0u && nd > 0) { const unsigned lowbit = e & (0u - e); add |= lowbit; e ^= lowbit; --nd; }
                if (add) lm[wd] |= add;
            }
        }
    }
    __syncthreads();
    for (int i = tid; i < 16 * 64; i += 512) { const int qq = i >> 6, wd = i & 63; MASK[(size_t)(row0 + qq) * 64 + wd] = ((const LAS unsigned*)lmask)[qq * 64 + wd]; }
    __syncthreads();
}

template <int KIND>
DI void tr_item(const float* __restrict__ W, const float* __restrict__ W2, const int ldw, const int Ksrc, const float* __restrict__ gk, bf16_t* __restrict__ WT, const int Kout,
                LAS float* scr, const int item, const int nblk, const int lane) {
    const int kb = item / nblk, nb = item % nblk, k0 = 64 * kb, n0 = 32 * nb;
    const int n = n0 + (lane & 31);
    int sc; const float* Wm = W;
    if (KIND == 0) sc = n;
    else if (KIND == 1) sc = win_src_col(n);
    else if (KIND == 2) sc = wuq_src_col(n);
    else { const int pn = n >> 8, r = n & 255; Wm = (r < 128) ? W : W2; sc = 128 * pn + (r & 127); }
#pragma unroll 8
    for (int i = 0; i < 32; ++i) { const int kk = 2 * i + (lane >> 5), k = k0 + kk;
        float v = 0.f;
        if (sc >= 0 && k < Ksrc) { v = Wm[(size_t)k * ldw + sc]; if (gk) v *= gk[k]; }
        scr[kk * 33 + (lane & 31)] = v; }
    asm volatile("s_waitcnt lgkmcnt(0)" ::: "memory");
    const int c = lane & 7;
#pragma unroll
    for (int j = 0; j < 4; ++j) { const int nn = (lane >> 3) + 8 * j; const LAS float* s = scr + (8 * c) * 33 + nn;
        u32x4 o; o.x = pk2(s[0 * 33], s[1 * 33]); o.y = pk2(s[2 * 33], s[3 * 33]); o.z = pk2(s[4 * 33], s[5 * 33]); o.w = pk2(s[6 * 33], s[7 * 33]);
        *(u32x4*)(WT + (size_t)(n0 + nn) * Kout + k0 + 8 * c) = o; }
    asm volatile("s_waitcnt lgkmcnt(0)" ::: "memory");
}
template <int KIND>
DI void tr_matrix(const float* W, const float* W2, int ldw, int Ksrc, const float* gk, bf16_t* WT, int Kout, int Nout, LAS float* scr, int gw, int NGW, int lane) {
    const int nblk = Nout / 32, items = (Kout / 64) * nblk;
    for (int it = gw; it < items; it += NGW) tr_item<KIND>(W, W2, ldw, Ksrc, gk, WT, Kout, scr, it, nblk, lane);
}

template <int KIND>
DI void trv_load(const float* __restrict__ W, const float* __restrict__ W2, const int ldw, const int Ksrc, const float* __restrict__ gk, const int item, const int nblk, const int lane, f32x4 (&v)[8]) {
    const int kb = item / nblk, nb = item % nblk, k0 = 32 * kb, n = 64 * nb + 4 * (lane & 15);
    const float* Wm = W; int sc = n;
    if (KIND == 1) sc = win_src_col(n);
    if (KIND == 2) sc = wuq_src_col(n);
    if (KIND == 4) { const int pn = n >> 8, r = n & 255; Wm = (r < 128) ? W : W2; sc = 128 * pn + (r & 127); }
#pragma unroll
    for (int i = 0; i < 8; ++i) { const int k = k0 + 4 * i + (lane >> 4);
        v[i] = (f32x4){0.f, 0.f, 0.f, 0.f};
        if (k < Ksrc && sc >= 0) { const float* p_ = Wm + (size_t)k * ldw + sc;
            if (KIND == 1 || KIND == 2) v[i] = (f32x4){p_[0], p_[1], p_[2], p_[3]}; else v[i] = *(const f32x4*)p_;
            if (gk) v[i] = v[i] * gk[k]; } }
}
DI void trv_store(bf16_t* __restrict__ WT, const int Kout, LAS float* scr, const int item, const int nblk, const int lane, const f32x4 (&v)[8]) {
    const int kb = item / nblk, nb = item % nblk, k0 = 32 * kb, n0 = 64 * nb;
#pragma unroll
    for (int i = 0; i < 8; ++i) { LAS float* d = scr + (4 * i + (lane >> 4)) * 65 + 4 * (lane & 15); d[0] = v[i][0]; d[1] = v[i][1]; d[2] = v[i][2]; d[3] = v[i][3]; }
    asm volatile("s_waitcnt lgkmcnt(0)" ::: "memory");
    const int c = lane & 3;
#pragma unroll
    for (int j = 0; j < 4; ++j) { const int nn = (lane >> 2) + 16 * j; const LAS float* s = scr + (8 * c) * 65 + nn;
        u32x4 o; o.x = pk2(s[0 * 65], s[1 * 65]); o.y = pk2(s[2 * 65], s[3 * 65]); o.z = pk2(s[4 * 65], s[5 * 65]); o.w = pk2(s[6 * 65], s[7 * 65]);
        *(u32x4*)(WT + (size_t)(n0 + nn) * Kout + k0 + 8 * c) = o; }
    asm volatile("s_waitcnt lgkmcnt(0)" ::: "memory");
}
template <int KIND>
DI void trv_matrix(const float* W, const float* W2, int ldw, int Ksrc, const float* gk, bf16_t* WT, int Kout, int Nout, LAS float* scr, int gw, int NGW, int lane) {
    const int nblk = Nout / 64, items = (Kout / 32) * nblk;
    for (int it = gw; it < items; it += 2 * NGW) {
        f32x4 va[8], vb[8]; const int it2 = it + NGW;
        trv_load<KIND>(W, W2, ldw, Ksrc, gk, it, nblk, lane, va);
        if (it2 < items) trv_load<KIND>(W, W2, ldw, Ksrc, gk, it2, nblk, lane, vb);
        trv_store(WT, Kout, scr, it, nblk, lane, va);
        if (it2 < items) trv_store(WT, Kout, scr, it2, nblk, lane, vb);
    }
}

DI unsigned pk4_i8(float a, float b, float c, float d) { const int ia = (int)__builtin_rintf(a), ib = (int)__builtin_rintf(b), ic = (int)__builtin_rintf(c), id = (int)__builtin_rintf(d);
    return ((unsigned)ia & 0xffu) | (((unsigned)ib & 0xffu) << 8) | (((unsigned)ic & 0xffu) << 16) | ((unsigned)id << 24); }
DI void q8_strip(const float* __restrict__ Wg, const float* __restrict__ Wu, const float* __restrict__ gk, unsigned char* __restrict__ W8, float* __restrict__ sb, const int strip, LAS float* scr, const int lane) {
    const int n0 = 32 * strip, pn = n0 >> 8, r = n0 & 255;
    const float* Wm = (r < 128) ? Wg : Wu; const int c0 = 128 * pn + (r & 127) + 4 * (lane & 7); const int kr = lane >> 3;
    f32x4 mx = (f32x4){0.f, 0.f, 0.f, 0.f};
#pragma unroll 16
    for (int it = 0; it < 128; ++it) { const int k = 8 * it + kr; const f32x4 v = *(const f32x4*)(Wm + (size_t)k * DFF + c0) * gk[k];
        mx[0] = fmaxf(mx[0], fabsf(v[0])); mx[1] = fmaxf(mx[1], fabsf(v[1])); mx[2] = fmaxf(mx[2], fabsf(v[2])); mx[3] = fmaxf(mx[3], fabsf(v[3])); }
    f32x4 inv;
#pragma unroll
    for (int e = 0; e < 4; ++e) { float m = mx[e]; m = fmaxf(m, __shfl_xor(m, 8)); m = fmaxf(m, __shfl_xor(m, 16)); m = fmaxf(m, __shfl_xor(m, 32)); mx[e] = m; inv[e] = m > 0.f ? 127.0f / m : 0.f; }
    if (lane < 8) *(f32x4*)(sb + n0 + 4 * lane) = (f32x4){mx[0] > 0.f ? mx[0] * (1.0f / 127.0f) : 1.0f, mx[1] > 0.f ? mx[1] * (1.0f / 127.0f) : 1.0f, mx[2] > 0.f ? mx[2] * (1.0f / 127.0f) : 1.0f, mx[3] > 0.f ? mx[3] * (1.0f / 127.0f) : 1.0f};
#pragma unroll 1
    for (int kb = 0; kb < 16; ++kb) {
        f32x4 v[8];
#pragma unroll
        for (int i = 0; i < 8; ++i) { const int k = 64 * kb + 8 * i + kr; v[i] = *(const f32x4*)(Wm + (size_t)k * DFF + c0) * gk[k] * inv; }
#pragma unroll
        for (int i = 0; i < 8; ++i) { LAS float* d = scr + (8 * i + kr) * 33 + 4 * (lane & 7); d[0] = v[i][0]; d[1] = v[i][1]; d[2] = v[i][2]; d[3] = v[i][3]; }
        asm volatile("s_waitcnt lgkmcnt(0)" ::: "memory");
        const int nn = lane & 31, kh = lane >> 5; const LAS float* s = scr + (32 * kh) * 33 + nn;
        u32x4 o0, o1;
        o0.x = pk4_i8(s[0 * 33], s[1 * 33], s[2 * 33], s[3 * 33]);     o0.y = pk4_i8(s[4 * 33], s[5 * 33], s[6 * 33], s[7 * 33]);
        o0.z = pk4_i8(s[8 * 33], s[9 * 33], s[10 * 33], s[11 * 33]);   o0.w = pk4_i8(s[12 * 33], s[13 * 33], s[14 * 33], s[15 * 33]);
        o1.x = pk4_i8(s[16 * 33], s[17 * 33], s[18 * 33], s[19 * 33]); o1.y = pk4_i8(s[20 * 33], s[21 * 33], s[22 * 33], s[23 * 33]);
        o1.z = pk4_i8(s[24 * 33], s[25 * 33], s[26 * 33], s[27 * 33]); o1.w = pk4_i8(s[28 * 33], s[29 * 33], s[30 * 33], s[31 * 33]);
        unsigned char* dst = W8 + (size_t)(n0 + nn) * 1024 + 64 * kb + 32 * kh;
        *(u32x4*)dst = o0; *(u32x4*)(dst + 16) = o1;
        asm volatile("s_waitcnt lgkmcnt(0)" ::: "memory");
    }
}
DI void q8_strip_wg(const float* __restrict__ Wg, const float* __restrict__ Wu, const float* __restrict__ gk, unsigned char* __restrict__ W8, float* __restrict__ sb, const int strip,
                    LAS float* scr, LAS float* xmax, const int w, const int lane) {
    const int n0 = 32 * strip, pn = n0 >> 8, r = n0 & 255;
    const float* Wm = (r < 128) ? Wg : Wu; const int c0 = 128 * pn + (r & 127) + 4 * (lane & 7); const int kr = lane >> 3, kw = 128 * w;
    f32x4 v[16]; f32x4 mx = (f32x4){0.f, 0.f, 0.f, 0.f};
#pragma unroll
    for (int it = 0; it < 16; ++it) { const int k = kw + 8 * it + kr; v[it] = *(const f32x4*)(Wm + (size_t)k * DFF + c0) * gk[k]; }
#pragma unroll
    for (int it = 0; it < 16; ++it) { mx[0] = fmaxf(mx[0], fabsf(v[it][0])); mx[1] = fmaxf(mx[1], fabsf(v[it][1])); mx[2] = fmaxf(mx[2], fabsf(v[it][2])); mx[3] = fmaxf(mx[3], fabsf(v[it][3])); }
#pragma unroll
    for (int e = 0; e < 4; ++e) { float m = mx[e]; m = fmaxf(m, __shfl_xor(m, 8)); m = fmaxf(m, __shfl_xor(m, 16)); m = fmaxf(m, __shfl_xor(m, 32)); mx[e] = m; }
    if (lane < 8) *(LAS f32x4*)(xmax + w * 32 + 4 * lane) = mx;
    __syncthreads();
    f32x4 inv;
    { f32x4 m = *(const LAS f32x4*)(xmax + 4 * (lane & 7));
#pragma unroll
      for (int ww = 1; ww < 8; ++ww) { const f32x4 o = *(const LAS f32x4*)(xmax + ww * 32 + 4 * (lane & 7)); m[0] = fmaxf(m[0], o[0]); m[1] = fmaxf(m[1], o[1]); m[2] = fmaxf(m[2], o[2]); m[3] = fmaxf(m[3], o[3]); }
#pragma unroll
      for (int e = 0; e < 4; ++e) inv[e] = m[e] > 0.f ? 127.0f / m[e] : 0.f;
      if (w == 0 && lane < 8) *(f32x4*)(sb + n0 + 4 * lane) = (f32x4){m[0] > 0.f ? m[0] * (1.0f / 127.0f) : 1.0f, m[1] > 0.f ? m[1] * (1.0f / 127.0f) : 1.0f, m[2] > 0.f ? m[2] * (1.0f / 127.0f) : 1.0f, m[3] > 0.f ? m[3] * (1.0f / 127.0f) : 1.0f}; }
#pragma unroll
    for (int hf = 0; hf < 2; ++hf) {
#pragma unroll
        for (int i = 0; i < 8; ++i) { const f32x4 q = v[8 * hf + i] * inv; LAS float* d = scr + (8 * i + kr) * 33 + 4 * (lane & 7); d[0] = q[0]; d[1] = q[1]; d[2] = q[2]; d[3] = q[3]; }
        asm volatile("s_waitcnt lgkmcnt(0)" ::: "memory");
        const int nn = lane & 31, kh = lane >> 5; const LAS float* s = scr + (32 * kh) * 33 + nn;
        u32x4 o0, o1;
        o0.x = pk4_i8(s[0 * 33], s[1 * 33], s[2 * 33], s[3 * 33]);     o0.y = pk4_i8(s[4 * 33], s[5 * 33], s[6 * 33], s[7 * 33]);
        o0.z = pk4_i8(s[8 * 33], s[9 * 33], s[10 * 33], s[11 * 33]);   o0.w = pk4_i8(s[12 * 33], s[13 * 33], s[14 * 33], s[15 * 33]);
        o1.x = pk4_i8(s[16 * 33], s[17 * 33], s[18 * 33], s[19 * 33]); o1.y = pk4_i8(s[20 * 33], s[21 * 33], s[22 * 33], s[23 * 33]);
        o1.z = pk4_i8(s[24 * 33], s[25 * 33], s[26 * 33], s[27 * 33]); o1.w = pk4_i8(s[28 * 33], s[29 * 33], s[30 * 33], s[31 * 33]);
        unsigned char* dst = W8 + (size_t)(n0 + nn) * 1024 + kw + 64 * hf + 32 * kh;
        *(u32x4*)dst = o0; *(u32x4*)(dst + 16) = o1;
        asm volatile("s_waitcnt lgkmcnt(0)" ::: "memory");
    }
    __syncthreads();
}
DI void trv8_store(unsigned char* __restrict__ WT, const int Kout, LAS float* scr, const int item, const int nblk, const int lane, const f32x4 (&v)[8]) {
    const int kb = item / nblk, nb = item % nblk, k0 = 32 * kb, n0 = 64 * nb;
#pragma unroll
    for (int i = 0; i < 8; ++i) { LAS float* d = scr + (4 * i + (lane >> 4)) * 65 + 4 * (lane & 15); d[0] = v[i][0]; d[1] = v[i][1]; d[2] = v[i][2]; d[3] = v[i][3]; }
    asm volatile("s_waitcnt lgkmcnt(0)" ::: "memory");
    const int c = lane & 3;
#pragma unroll
    for (int j = 0; j < 4; ++j) { const int nn = (lane >> 2) + 16 * j; const LAS float* s = scr + (8 * c) * 65 + nn;
        u32x2 o; o.x = pk4_fp8(WD_SCALE * s[0 * 65], WD_SCALE * s[1 * 65], WD_SCALE * s[2 * 65], WD_SCALE * s[3 * 65]); o.y = pk4_fp8(WD_SCALE * s[4 * 65], WD_SCALE * s[5 * 65], WD_SCALE * s[6 * 65], WD_SCALE * s[7 * 65]);
        *(u32x2*)(WT + (size_t)(n0 + nn) * Kout + k0 + 8 * c) = o; }
    asm volatile("s_waitcnt lgkmcnt(0)" ::: "memory");
}
DI void trv8_matrix(const float* W, int ldw, int Ksrc, unsigned char* WT, int Kout, int Nout, LAS float* scr, int gw, int NGW, int lane) {
    const int nblk = Nout / 64, items = (Kout / 32) * nblk;
    for (int it = gw; it < items; it += 2 * NGW) {
        f32x4 va[8], vb[8]; const int it2 = it + NGW;
        trv_load<0>(W, nullptr, ldw, Ksrc, nullptr, it, nblk, lane, va);
        if (it2 < items) trv_load<0>(W, nullptr, ldw, Ksrc, nullptr, it2, nblk, lane, vb);
        trv8_store(WT, Kout, scr, it, nblk, lane, va);
        if (it2 < items) trv8_store(WT, Kout, scr, it2, nblk, lane, vb);
    }
}
DI void quant_regs(const f32x4 (&v)[4], unsigned char* __restrict__ q8row, float* __restrict__ ra, const int lane, float& rstd) {
    float s = 0.f, mx = 0.f;
#pragma unroll
    for (int j = 0; j < 4; ++j) { s += dot4(v[j]); mx = fmaxf(fmaxf(mx, fmaxf(fabsf(v[j][0]), fabsf(v[j][1]))), fmaxf(fabsf(v[j][2]), fabsf(v[j][3]))); }
    s = wave_sum(s);
#pragma unroll
    for (int o = 1; o < 64; o <<= 1) mx = fmaxf(mx, __shfl_xor(mx, o));
    rstd = 1.0f / sqrtf(s * (1.0f / 1024.0f) + EPS);
    const float inv = mx > 0.f ? 127.0f / mx : 0.f;
    unsigned* q = (unsigned*)q8row + lane;
#pragma unroll
    for (int j = 0; j < 4; ++j) q[64 * j] = pk4_i8(v[j][0] * inv, v[j][1] * inv, v[j][2] * inv, v[j][3] * inv);
    if (lane == 0) *ra = rstd * (mx > 0.f ? mx * (1.0f / 127.0f) : 1.0f);
}
DI void load_row(const float* __restrict__ hrow, const int lane, f32x4 (&v)[4]) { const f32x4* hr = (const f32x4*)hrow + lane;
#pragma unroll
    for (int j = 0; j < 4; ++j) v[j] = hr[64 * j]; }

DI void load_row_bf(const bf16_t* __restrict__ hrow, const int lane, f32x4 (&v)[4]) { const u32x2* hr = (const u32x2*)hrow + lane;
#pragma unroll
    for (int j = 0; j < 4; ++j) { const u32x2 y = hr[64 * j]; v[j][0] = __uint_as_float(y.x << 16); v[j][1] = __uint_as_float(y.x & 0xffff0000u); v[j][2] = __uint_as_float(y.y << 16); v[j][3] = __uint_as_float(y.y & 0xffff0000u); } }

struct Args { const float* in[23]; float* out; unsigned char* ws; double invfreq[NFREQ]; int ph_lo, ph_hi; };

DI void moe_tables(const unsigned* ecnt, LAS int* tbase, LAS int* tile_e, int tid) {
    if (tid == 0) { int acc = 0; for (int l = 0; l < 16; ++l) { tbase[l] = acc; const int n = (int)__hip_atomic_load(ecnt + 64 * l, RLX_AGENT); acc += (n + 255) >> 8; } tbase[16] = acc; }
    __syncthreads();
    for (int t = tid; t < MAXSLOT_TILES; t += 512) { int l = 0; for (int k = 1; k < 16; ++k) l = (t >= tbase[k]) ? k : l; tile_e[t] = l; }
    __syncthreads();
}

#define KARG ((const __attribute__((address_space(4))) Args*)__builtin_amdgcn_kernarg_segment_ptr())
DI const __attribute__((address_space(4))) Args* karg_l() { auto p = KARG; asm volatile("" : "+s"(p)); return p; }
#define INP(i) (karg_l()->in[i])
#define OUTP() (karg_l()->out)
#define WSP() (karg_l()->ws)
#define WSF(off) ((float*)(WSP() + (off)))
#define WSI(off) ((int*)(WSP() + (off)))
#define WSB(off) ((bf16_t*)(WSP() + (off)))
#define HBP() ((bf16_t*)OUTP())
__global__ void __launch_bounds__(512, 2) fwd_kernel(Args args) {
    extern __shared__ __attribute__((aligned(16))) unsigned char lds_raw[];
    LAS unsigned char* lds = (LAS unsigned char*)lds_raw;
    volatile LAS unsigned* MISC = (volatile LAS unsigned*)(lds + MISC_OFF);
    LAS int* tbase = (LAS int*)(lds + LDSX_OFF);
    LAS int* tile_e = (LAS int*)(lds + LDSX_OFF + 128);
    const int tid = threadIdx.x, lane = tid & 63; const int wave = __builtin_amdgcn_readfirstlane(tid >> 6);
    const int G = gridDim.x; const int vcu = (G % 8 == 0) ? ((int)blockIdx.x % 8) * (G / 8) + (int)blockIdx.x / 8 : (int)blockIdx.x;
    const int gw = vcu * 8 + wave, NGW = G * 8;
    unsigned* ctl = (unsigned*)(WSP() + WS_CTL);
    for (int u = tid; u < (LDS_BYTES - RING_BYTES) / 4; u += 512) ((LAS unsigned*)(lds + RING_BYTES))[u] = 0u;
    __syncthreads();
    XcdBarrier bar = xcd_barrier_post(ctl + CW_BAR, MISC + 8);
    const int lo = KARG->ph_lo, hi = KARG->ph_hi;
    int ph = 0;
#ifndef PHMASK
#define PHMASK 0xffffffffu
#endif
#define PHON(k) (((PHMASK) >> (k)) & 1u)
#ifndef DUPMASK
#define DUPMASK 0u
#endif
#define DUPN(k) ((((DUPMASK) >> (k)) & 1u) ? 2 : 1)
#define DUP_BEGIN(k) for (int rep = DUPN(k) - 1; rep >= 0; --rep) { const float ascale = rep ? 0.f : 1.f; (void)ascale;
#define DUP_END() if (rep) xcd_barrier(bar); }
#define IN_PH() (lo <= ph && ph < hi)
#define SEAM() do { if (lo <= ph && ph + 1 < hi) xcd_barrier(bar); ++ph; } while (0)
    if (PHON(0) && IN_PH()) { DUP_BEGIN(0)
        LAS float* scr = (LAS float*)(lds + wave * 16384);
        for (int l = 0; l < 2; ++l) {
            unsigned char* wl = WSP() + WS_WSMALL + (size_t)l * WO_L1;
            trv_matrix<1>(INP(3) + (size_t)l * 1024 * NIN, nullptr, NIN, 1024, INP(2) + l * 1024, (bf16_t*)(wl + WO_IN0), 1024, NINP, scr, gw, NGW, lane);
            trv_matrix<2>(INP(5) + (size_t)l * 256 * 768, nullptr, 768, 256, INP(4) + l * 256, (bf16_t*)(wl + WO_UQ0), 256, 768, scr, gw, NGW, lane);
            trv_matrix<0>(INP(7) + (size_t)l * 128 * 1024, nullptr, 1024, 128, INP(6) + l * 128, (bf16_t*)(wl + WO_UKV0), 256, 1024, scr, gw, NGW, lane);
            trv_matrix<0>(INP(13) + (size_t)l * 1024 * 1024, nullptr, 1024, 1024, nullptr, (bf16_t*)(wl + WO_OUT0), 1024, 1024, scr, gw, NGW, lane);
        }
        for (int s = vcu; s < 2 * DFF / 32; s += G) q8_strip_wg(INP(15), INP(16), INP(14), WSP() + WS_WSMALL + WO_GU, WSF(WS_SBD), s, scr, (LAS float*)(lds + 8 * 16384 - 1024), wave, lane);
        trv8_matrix(INP(17), 1024, DFF, WSP() + WS_WSMALL + WO_D, DFF, 1024, scr, gw, NGW, lane);
        { f32x4 nv[4]; if (gw < MTOK) load_row(INP(0) + (size_t)gw * DM, lane, nv);
        for (int m = gw; m < MTOK; m += NGW) {
            f32x4 v[4]; float s = 0.f;
#pragma unroll
            for (int j = 0; j < 4; ++j) { v[j] = nv[j]; s += dot4(v[j]); }
            if (m + NGW < MTOK) load_row(INP(0) + (size_t)(m + NGW) * DM, lane, nv);
            s = wave_sum(s);
            u32x2* o8 = (u32x2*)(HBP() + (size_t)m * DM) + lane;
#pragma unroll
            for (int j = 0; j < 4; ++j) { u32x2 o; o.x = pk2(v[j][0], v[j][1]); o.y = pk2(v[j][2], v[j][3]); o8[64 * j] = o; }
            if (lane < 16) WSF(WS_SSQA)[(size_t)m * 16 + lane] = (lane == 0) ? s : 0.f;
        } }
        for (int i = (vcu * 512 + tid); i < MTOK * NFREQ; i += G * 512) {
            const int m = i / NFREQ, f = i % NFREQ;
            const double a = (double)((const int*)INP(1))[m] * KARG->invfreq[f];
            const double kq = __builtin_rint(a * 0.15915494309189535);
            const float r = (float)(a - kq * 6.283185307179586);
            WSF(WS_CS)[(size_t)m * CSW + f] = cosf(r); WSF(WS_CS)[(size_t)m * CSW + NFREQ + f] = sinf(r);
        }
     DUP_END() }
    SEAM();

    for (int l = 0; l < 2; ++l) {
        const unsigned char* wl = WSP() + WS_WSMALL + (size_t)l * WO_L1;
        if (PHON(1) && IN_PH()) { DUP_BEGIN(1)
            SchedDense S; S.T.init(MTOK / 256, NINP / 256, G, (int)blockIdx.x, 0); S.lda2 = DM * 2; S.arow0 = 0; S.A = (const char*)HBP(); S.Bt = (const char*)(wl + WO_IN0); S.btile = (size_t)256 * 1024 * 2;
            EpiIn E{WSB(WS_P), WSF(WS_SSQA), WSF(WS_CS), WSF(WS_SSQCQ), WSF(WS_SSQCKV), ctl + CW_FLAGS + 16 * 256 * l};
            pg8::gemm_phase<0, EpiIn, SchedDense, true>(lds, 2048, S, E);
         DUP_END() }
        auto wait_tiles = [&](const pg8::TileOrder& T, const int k) {
            if (PHON(1)) {
                if (threadIdx.x == 0) { pg8::Unit u;
                    for (int i = 0; T.next(i, u); ++i) { unsigned* f = ctl + CW_FLAGS + 16 * 256 * l + 16 * (u.pm * 2 + k); unsigned sp = 0u;
                        while (__hip_atomic_load(f, __ATOMIC_RELAXED, __HIP_MEMORY_SCOPE_AGENT) == 0u) { __builtin_amdgcn_s_sleep(2); if (++sp > (1u << 26)) break; } }
                    __builtin_amdgcn_fence(__ATOMIC_ACQUIRE, "agent"); }
                __syncthreads();
            }
        };
        if (PHON(2) && IN_PH()) { DUP_BEGIN(2)
#ifndef NO_G2
            { SchedDense S; S.T.init(MTOK / 256, 3, G, G - 1 - (int)blockIdx.x, 0); wait_tiles(S.T, 0); S.lda2 = PP * 2; S.arow0 = 0; S.A = (const char*)(WSB(WS_P) + TCQ); S.Bt = (const char*)(wl + WO_UQ0); S.btile = (size_t)256 * 256 * 2;
              EpiLat<true> E{WSB(WS_QC), 768, WSF(WS_SSQCQ), 1.0f / 256.0f, WSF(WS_CS)};
              pg8::gemm_phase<0, EpiLat<true>, SchedDense, true>(lds, 512, S, E); }
#endif
         DUP_END() }
        if (PHON(13) && IN_PH()) { DUP_BEGIN(13)
#ifndef NO_G3
            { SchedDense S; S.T.init(MTOK / 256, 4, G, (int)blockIdx.x, 0); wait_tiles(S.T, 1); S.lda2 = PP * 2; S.arow0 = 0; S.A = (const char*)(WSB(WS_P) + TCKV); S.Bt = (const char*)(wl + WO_UKV0); S.btile = (size_t)256 * 256 * 2;
              EpiLat<false> E{WSB(WS_KV), 1024, WSF(WS_SSQCKV), 1.0f / 128.0f, WSF(WS_CS)};
              pg8::gemm_phase<0, EpiLat<false>, SchedDense, true>(lds, 512, S, E); }
#endif
         DUP_END() }
        SEAM();
        if (PHON(3) && IN_PH()) { DUP_BEGIN(3)
            int tid = threadIdx.x; asm volatile("" : "+v"(tid));
            unsigned* qc = ctl + CW_QUEUE + 64 * (2 * l + 4 * rep);
            for (;;) {
                if (tid == 0) MISC[0] = __hip_atomic_fetch_add(qc, 1u, RLX_AGENT);
                __syncthreads();
                const int i = (int)MISC[0];
                __syncthreads();
                if (i >= 1024 + 1792) break;
                if (i < 1024) { const int qb = 7 - i / 128, rem = i % 128; attn_unit<0>(lds, WSB(WS_P), WSB(WS_QC), WSB(WS_KV), ((unsigned*)(WSP() + WS_MASK)), WSB(WS_RA), rem / 8, rem % 8, qb, nullptr, 0.f, 0.f); }
                else { const int j = i - 1024; idx_unit(lds, WSB(WS_P), ((unsigned*)(WSP() + WS_MASK)), j % 16, 127 - j / 16); }
            }
         DUP_END() }
        SEAM();
        if (PHON(4) && IN_PH()) { DUP_BEGIN(4)
            int tid = threadIdx.x; asm volatile("" : "+v"(tid)); const int lane = tid & 63;
            const float lam_init = (l == 0) ? 0.2f : (0.8f - 0.6f * 0.7408182206817179f);
            float lam;
            { const float* q1 = INP(8) + l * 32; const float* k1 = INP(9) + l * 32; const float* q2 = INP(10) + l * 32; const float* k2 = INP(11) + l * 32;
              float a = (lane < 32) ? q1[lane] * k1[lane] : 0.f, bq = (lane < 32) ? q2[lane] * k2[lane] : 0.f; a = wave_sum(a); bq = wave_sum(bq); lam = expf(a) - expf(bq) + lam_init; }
            unsigned* qc = ctl + CW_QUEUE + 64 * (2 * l + 1 + 4 * rep);
            for (;;) {
                if (tid == 0) MISC[0] = __hip_atomic_fetch_add(qc, 1u, RLX_AGENT);
                __syncthreads();
                const int i = (int)MISC[0];
                __syncthreads();
                if (i >= 1024 + 512) break;
#ifndef NO_DIFF
                if (i < 1024) { const int qb = 15 - i / 64, rem = i % 64; attn_unit<1>(lds, WSB(WS_P), WSB(WS_QC), WSB(WS_KV), ((unsigned*)(WSP() + WS_MASK)), WSB(WS_RA), rem / 4, rem % 4, qb, INP(12) + l * 64, lam, 1.0f - lam_init); }
                else
#endif
#ifndef NO_DSA
                { const int j = i - 1024; attn_unit<2>(lds, WSB(WS_P), WSB(WS_QC), WSB(WS_KV), ((unsigned*)(WSP() + WS_MASK)), WSB(WS_RA), j % 16, 0, 31 - j / 16, nullptr, 0.f, 0.f); }
#endif
                ;
            }
         DUP_END() }
        SEAM();
        if (PHON(5) && IN_PH()) { DUP_BEGIN(5)
            SchedDense S; S.T.init(MTOK / 256, 4, G, (int)blockIdx.x, 0); S.lda2 = DM * 2; S.arow0 = 0; S.A = (const char*)WSB(WS_RA); S.Bt = (const char*)(wl + WO_OUT0); S.btile = (size_t)256 * 1024 * 2;
            EpiResB E{HBP(), nullptr, ascale};
            pg8::gemm_phase<0, EpiResB, SchedDense, true>(lds, 2048, S, E);
         DUP_END() }
        SEAM();
        if (l == 0) {
            if (PHON(14) && IN_PH()) {
                int tid = threadIdx.x; asm volatile("" : "+v"(tid)); const int lane = tid & 63;
                for (int m = gw; m < MTOK; m += NGW) { f32x4 v[4]; float rstd; load_row_bf(HBP() + (size_t)m * DM, lane, v); quant_regs(v, WSP() + WS_HB8 + (size_t)m * DM, WSF(WS_RSTDTOK) + m, lane, rstd); }
            }
            SEAM();
            if (PHON(6) && IN_PH()) { DUP_BEGIN(6)
                SchedDense S; S.T.init(MTOK / 256, 28, G, (int)blockIdx.x, 0); S.lda2 = DM; S.arow0 = 0; S.A = (const char*)(WSP() + WS_HB8); S.Bt = (const char*)(WSP() + WS_WSMALL + WO_GU); S.btile = (size_t)256 * 1024;
                EpiGU8<false> E{WSP() + WS_ACT8, WSF(WS_RSTDTOK), WSF(WS_SBD), nullptr, tile_e};
                pg8::gemm_phase<1, EpiGU8<false>, SchedDense, true>(lds, 1024, S, E);
             DUP_END() }
            SEAM();
            if (PHON(7) && IN_PH()) { DUP_BEGIN(7)
                SchedDense S; S.T.init(MTOK / 256, 4, G, (int)blockIdx.x, 0); S.lda2 = DFF; S.arow0 = 0; S.A = (const char*)(WSP() + WS_ACT8); S.Bt = (const char*)(WSP() + WS_WSMALL + WO_D); S.btile = (size_t)256 * DFF;
                EpiResB E{HBP(), WSF(WS_SSQA), ascale * (1.0f / (ACT_SCALE * WD_SCALE))};
                pg8::gemm_phase<2, EpiResB, SchedDense, true>(lds, DFF, S, E);
             DUP_END() }
            SEAM();
        } else {
            if (PHON(8) && IN_PH()) {
                int tid = threadIdx.x; asm volatile("" : "+v"(tid)); const int lane = tid & 63;
                LAS float* scr = (LAS float*)(lds + wave * 16384);
                for (int s = vcu; s < NEXP * (2 * DFF / 32); s += G) { const int e = s / (2 * DFF / 32), ss = s % (2 * DFF / 32);
                    q8_strip_wg(INP(19) + (size_t)e * 1024 * DFF, INP(20) + (size_t)e * 1024 * DFF, INP(14) + 1024, WSP() + WS_WMOE + (size_t)e * WB_GU, WSF(WS_SBM) + (size_t)e * 2 * DFF, ss, scr, (LAS float*)(lds + 8 * 16384 - 1024), wave, lane); }
                for (int e = 0; e < NEXP; ++e) trv8_matrix(INP(21) + (size_t)e * DFF * 1024, 1024, DFF, WSP() + WS_WMOE + (size_t)NEXP * WB_GU + (size_t)e * WB_D, DFF, 1024, scr, gw, NGW, lane);
                __syncthreads();
                for (int i = vcu * 512 + tid; i < MAXSLOTS; i += G * 512) WSI(WS_ROWTOK)[i] = -1;
                LAS int* lcnt = (LAS int*)lds;
                LAS int* ltk = (LAS int*)(lds + 256);
                LAS float* lgt = (LAS float*)(lds + 256 + 2048);
                if (tid < 32) lcnt[tid] = 0;
                __syncthreads();
                if (G * 128 >= MTOK) {
                    LAS float* plog = (LAS float*)(lds + 4096) + wave * 16 * 9;
                    {
                        float gr[16][8];
                        { const float* gn = INP(14) + 1024; const float* rt = INP(18);
#pragma unroll
                          for (int j = 0; j < 4; ++j)
#pragma unroll
                              for (int i = 0; i < 4; ++i) { const int k = 256 * j + 4 * lane + i; const float gk = gn[k]; const f32x4 r0 = *(const f32x4*)(rt + k * 8), r1 = *(const f32x4*)(rt + k * 8 + 4);
#pragma unroll
                                  for (int e = 0; e < 4; ++e) { gr[4 * j + i][e] = gk * r0[e]; gr[4 * j + i][4 + e] = gk * r1[e]; } } }
                        const int m0 = vcu * 128 + wave * 16;
                        f32x4 nv[4]; load_row_bf(HBP() + (size_t)m0 * DM, lane, nv);
#pragma unroll 1
                        for (int tt = 0; tt < 16; ++tt) {
                            const int m = m0 + tt;
                            f32x4 v[4]; float rstd_m;
#pragma unroll
                            for (int j = 0; j < 4; ++j) v[j] = nv[j];
                            if (tt + 1 < 16) load_row_bf(HBP() + (size_t)(m + 1) * DM, lane, nv);
                            quant_regs(v, WSP() + WS_HB8 + (size_t)m * DM, WSF(WS_RSTDTOK) + m, lane, rstd_m);
                            float lg[8];
#pragma unroll
                            for (int e = 0; e < 8; ++e) { float a = 0.f;
#pragma unroll
                                for (int j = 0; j < 4; ++j)
#pragma unroll
                                    for (int i = 0; i < 4; ++i) a += v[j][i] * gr[4 * j + i][e];
                                lg[e] = wave_sum(a); }
                            if (lane == 0) {
#pragma unroll
                                for (int e = 0; e < 8; ++e) plog[tt * 9 + e] = lg[e];
                                plog[tt * 9 + 8] = rstd_m; }
                        }
                    }
                    asm volatile("s_waitcnt lgkmcnt(0)" ::: "memory");
                    if (lane < 16) {
                        const int tl = wave * 16 + lane, m = vcu * 128 + tl;
                        if (m < MTOK) {
                            const float rstd = plog[lane * 9 + 8];
                            float lg[8];
#pragma unroll
                            for (int e = 0; e < 8; ++e) lg[e] = plog[lane * 9 + e] * rstd;
                            int e1 = 0; float v1 = lg[0];
#pragma unroll
                            for (int e = 1; e < 8; ++e) if (lg[e] > v1) { v1 = lg[e]; e1 = e; }
                            int e2 = -1; float v2 = -INFINITY;
#pragma unroll
                            for (int e = 0; e < 8; ++e) if (e != e1 && lg[e] > v2) { v2 = lg[e]; e2 = e; }
                            const float g2 = 1.0f / (1.0f + expf(v1 - v2)), g1 = 1.0f - g2;
                            const int p1 = __hip_atomic_fetch_add(lcnt + e1, 1, __ATOMIC_RELAXED, __HIP_MEMORY_SCOPE_WORKGROUP);
                            const int p2 = __hip_atomic_fetch_add(lcnt + 8 + e2, 1, __ATOMIC_RELAXED, __HIP_MEMORY_SCOPE_WORKGROUP);
                            ltk[tl * 4 + 0] = e1; ltk[tl * 4 + 1] = p1; ltk[tl * 4 + 2] = 8 + e2; ltk[tl * 4 + 3] = p2; lgt[tl * 2] = g1; lgt[tl * 2 + 1] = g2;
                        }
                    }
                    __syncthreads();
                    if (tid < 16) lcnt[16 + tid] = (int)__hip_atomic_fetch_add((ctl + CW_ECNT) + 64 * tid, (unsigned)lcnt[tid], RLX_AGENT);
                    __syncthreads();
                    if (tid < 128) { const int m = vcu * 128 + tid;
                        if (m < MTOK) { const int l1 = ltk[tid * 4], l2 = ltk[tid * 4 + 2];
                            WSI(WS_TOKLIST)[2 * m] = l1; WSI(WS_TOKLIST)[2 * m + 1] = l2; WSI(WS_TOKPOS)[2 * m] = lcnt[16 + l1] + ltk[tid * 4 + 1]; WSI(WS_TOKPOS)[2 * m + 1] = lcnt[16 + l2] + ltk[tid * 4 + 3];
                            WSF(WS_TOKGATE)[2 * m] = lgt[tid * 2]; WSF(WS_TOKGATE)[2 * m + 1] = lgt[tid * 2 + 1]; } }
                }
                __syncthreads();
            }
            SEAM();
            if (PHON(9) && IN_PH()) {
                int tid = threadIdx.x; asm volatile("" : "+v"(tid));
                moe_tables((ctl + CW_ECNT), tbase, tile_e, tid);
                for (int i = vcu * 512 + tid; i < MTOK * 2; i += G * 512) {
                    const int slot = tbase[WSI(WS_TOKLIST)[i]] * 256 + WSI(WS_TOKPOS)[i];
                    WSI(WS_ROWTOK)[slot] = i >> 1; WSF(WS_ROWGATE)[slot] = WSF(WS_TOKGATE)[i];
                }
            }
            SEAM();
            if (lo > ph - 1) moe_tables((ctl + CW_ECNT), tbase, tile_e, tid);
            const int ntile = tbase[16];
            if (PHON(10) && IN_PH() && ntile > 0) { DUP_BEGIN(10)
                SchedMoeGU S; S.T.init(ntile, 28, G, (int)blockIdx.x, 0); S.lda2 = DM; S.A = (const char*)(WSP() + WS_HB8); S.rowtok = WSI(WS_ROWTOK); S.tile_e = tile_e; S.Bt = (const char*)(WSP() + WS_WMOE); S.btile = (size_t)256 * 1024; S.estride = WB_GU;
                EpiGU8<true> E{WSP() + WS_ACT8, WSF(WS_RSTDTOK), WSF(WS_SBM), WSI(WS_ROWTOK), tile_e};
                pg8::gemm_phase<1, EpiGU8<true>, SchedMoeGU, true>(lds, 1024, S, E);
             DUP_END() }
            SEAM();
            if (PHON(11) && IN_PH() && ntile > 0) { DUP_BEGIN(11)
                SchedMoeD S; S.T.init(ntile, 4, G, (int)blockIdx.x, 0); S.lda2 = DFF; S.arow0 = 0; S.A = (const char*)(WSP() + WS_ACT8); S.tile_e = tile_e; S.Bt = (const char*)(WSP() + WS_WMOE + (size_t)NEXP * WB_GU); S.btile = (size_t)256 * DFF; S.estride = WB_D;
                EpiDownMoe E{HBP(), WSB(WS_RA), WSI(WS_ROWTOK), WSF(WS_ROWGATE), tile_e, ascale * (1.0f / (ACT_SCALE * WD_SCALE))};
                pg8::gemm_phase<2, EpiDownMoe, SchedMoeD, true>(lds, DFF, S, E);
             DUP_END() }
            SEAM();
        }
    }
    if (PHON(12) && IN_PH()) {
        int tid = threadIdx.x; asm volatile("" : "+v"(tid)); const int lane = tid & 63;
        const float* gf = INP(22);
        u32x2 hreg[16][4];
#pragma unroll
        for (int r = 0; r < 16; ++r) { const u32x2* hr = (const u32x2*)(HBP() + (size_t)(gw + r * NGW) * DM) + lane;
#pragma unroll
            for (int j = 0; j < 4; ++j) hreg[r][j] = hr[64 * j]; }
        xcd_barrier(bar);
        f32x4 g4[4];
#pragma unroll
        for (int j = 0; j < 4; ++j) g4[j] = *((const f32x4*)gf + 64 * j + lane);
#pragma unroll
        for (int r = 0; r < 16; ++r) {
            const int m = gw + r * NGW;
            f32x4* orow = (f32x4*)(OUTP() + (size_t)m * DM) + lane; const u32x2* yr = (const u32x2*)(WSB(WS_RA) + (size_t)m * DM) + lane; f32x4 v[4]; float s = 0.f;
#pragma unroll
            for (int j = 0; j < 4; ++j) { const u32x2 y = yr[64 * j];
                v[j] = bf2lo(hreg[r][j].x, hreg[r][j].y) + bf2lo(y.x, y.y);
                s += dot4(v[j]); }
            s = wave_sum(s);
            const float rstd = 1.0f / sqrtf(s * (1.0f / 1024.0f) + EPS);
#pragma unroll
            for (int j = 0; j < 4; ++j) orow[64 * j] = v[j] * rstd * g4[j];
        }
    }
#undef IN_PH
#undef SEAM
}

extern "C" void kernel_launch(void* const* d_in, const int* in_sizes, int n_in, void* d_out, int out_size, void* d_ws, size_t ws_size, hipStream_t stream) {
    static int grid = 0;
    if (grid == 0) {
        if (n_in != 23 || out_size != MTOK * DM || ws_size < WS_END) { fprintf(stderr, "kernel_launch: unexpected shapes (n_in %d out %d ws %zu need %zu)\n", n_in, out_size, ws_size, (size_t)WS_END); grid = -1; return; }
        int dev = 0, cus = 0, per_cu = 0;
        if (hipGetDevice(&dev) != hipSuccess || hipDeviceGetAttribute(&cus, hipDeviceAttributeMultiprocessorCount, dev) != hipSuccess) { grid = -1; return; }
        if (hipFuncSetAttribute((const void*)fwd_kernel, hipFuncAttributeMaxDynamicSharedMemorySize, LDS_BYTES) != hipSuccess) { fprintf(stderr, "kernel_launch: hipFuncSetAttribute failed\n"); grid = -1; return; }
        if (hipOccupancyMaxActiveBlocksPerMultiprocessor(&per_cu, (const void*)fwd_kernel, 512, LDS_BYTES) != hipSuccess || per_cu < 1) { fprintf(stderr, "kernel_launch: occupancy query says %d\n", per_cu); (void)hipGetLastError(); grid = -1; return; }
        grid = cus;
    }
    if (grid < 0) return;
    (void)hipMemsetAsync((char*)d_ws + WS_CTL, 0, CTL_ZERO_BYTES, stream);
    Args a{};
    for (int i = 0; i < 23; ++i) a.in[i] = (const float*)d_in[i];
    a.out = (float*)d_out; a.ws = (unsigned char*)d_ws;
    for (int i = 0; i < 8; ++i) a.invfreq[i] = pow(500000.0, -((double)i * 2.0 / 16.0));
    for (int i = 0; i < 4; ++i) a.invfreq[8 + i] = pow(500000.0, -((double)i * 2.0 / 8.0));
    for (int i = 0; i < 16; ++i) a.invfreq[12 + i] = pow(500000.0, -((double)i * 2.0 / 32.0));
    a.ph_lo = 0; a.ph_hi = 1000;
    hipLaunchKernelGGL(fwd_kernel, dim3(grid), dim3(512), LDS_BYTES, stream, a);
}
```

```cpp
#include <hip/hip_runtime.h>
#include <hip/hip_bf16.h>
#include <cstdio>
#include <cstdint>
#include <cmath>

#define GAS __attribute__((address_space(1)))
#define LAS __attribute__((address_space(3)))
typedef unsigned short bf16_t;
typedef short bf16x8 __attribute__((ext_vector_type(8)));
typedef short s16x4 __attribute__((ext_vector_type(4)));
typedef float f32x4 __attribute__((ext_vector_type(4)));
typedef float f32x2 __attribute__((ext_vector_type(2)));
typedef float f32x16 __attribute__((ext_vector_type(16)));
typedef unsigned u32x4 __attribute__((ext_vector_type(4)));
typedef unsigned u32x2 __attribute__((ext_vector_type(2)));
typedef __bf16 bf16x2_t __attribute__((ext_vector_type(2)));
typedef int i32x4 __attribute__((ext_vector_type(4)));
typedef int i32x8 __attribute__((ext_vector_type(8)));
#define DI __device__ __forceinline__

constexpr int NB = 16, SEQ = 2048, DM = 1024, MTOK = NB * SEQ;
constexpr int NIN = 2152, PP = 2176;
constexpr int DFF = 3584, NEXP = 8;
constexpr float EPS = 1e-6f;
constexpr int TQA = 0, TQI = 256, TQB = 768, TKB = 1024, TVB = 1280, TCQ = 1536, TCKV = 1792, TKA = 1920, TVA = 1984, TKI = 2048, TKR = 2112, TWI = 2144;
constexpr int NINP = 2304;
constexpr int NFREQ = 28;
constexpr int CSW = 2 * NFREQ;
constexpr int MAXSLOT_TILES = 272;
constexpr int MAXSLOTS = MAXSLOT_TILES * 256;

constexpr size_t MiB = 1u << 20;
constexpr size_t WS_CTL = 0, CTL_ZERO_BYTES = 128 * 1024;
constexpr size_t WS_CS = 1 * MiB;
constexpr size_t WS_SSQA = 8 * MiB;
constexpr size_t WS_SSQH = 10 * MiB;
constexpr size_t WS_SSQCQ = 12 * MiB;
constexpr size_t WS_SSQCKV = 12 * MiB + 512 * 1024;
constexpr size_t WS_RSTDTOK = 13 * MiB;
constexpr size_t WS_TOKLIST = 13 * MiB + 128 * 1024;
constexpr size_t WS_TOKPOS = 13 * MiB + 384 * 1024;
constexpr size_t WS_TOKGATE = 13 * MiB + 640 * 1024;
constexpr size_t WS_ROWTOK = 14 * MiB;
constexpr size_t WS_ROWGATE = 14 * MiB + 512 * 1024;
constexpr size_t WS_WSMALL = 20 * MiB;
constexpr size_t WS_RA = 60 * MiB;
constexpr size_t WS_BIG = 124 * MiB;
constexpr size_t WS_P = WS_BIG;
constexpr size_t WS_QC = WS_BIG + 136 * MiB;
constexpr size_t WS_KV = WS_BIG + 184 * MiB;
constexpr size_t WS_MASK = WS_BIG + 248 * MiB;
constexpr size_t WS_HB8 = WS_BIG;
constexpr size_t WS_ACT8 = WS_BIG + 32 * MiB;
constexpr size_t WS_WMOE = WS_BIG + 270 * MiB;
constexpr size_t WS_END = WS_BIG + 354 * MiB;
constexpr size_t WS_SBD = 15 * MiB;
constexpr size_t WS_SBM = 15 * MiB + 64 * 1024;
constexpr size_t WB_IN = (size_t)NINP * 1024 * 2, WB_UQ = 768 * 256 * 2, WB_UKV = 1024 * 256 * 2, WB_OUT = 1024 * 1024 * 2, WB_GU = (size_t)2 * DFF * 1024, WB_D = (size_t)1024 * DFF;
constexpr size_t WO_IN0 = 0, WO_UQ0 = WO_IN0 + WB_IN, WO_UKV0 = WO_UQ0 + WB_UQ, WO_OUT0 = WO_UKV0 + WB_UKV, WO_L1 = WO_OUT0 + WB_OUT;
constexpr size_t WO_GU = 2 * WO_L1, WO_D = WO_GU + WB_GU, WO_END = WO_D + WB_D;
static_assert(WO_END <= 40 * MiB, "small weights fit");
static_assert((size_t)NEXP * (WB_GU + WB_D) <= 84 * MiB, "moe weights fit");
static_assert((size_t)MAXSLOTS * DFF <= 238 * MiB, "act fits");
constexpr float ACT_SCALE = 8.0f, WD_SCALE = 64.0f;
constexpr float LOG2E = 1.4426950408889634f;
constexpr float QS_DSA = 0.125f * LOG2E, QS_DIFF = 0.17677669529663687f * LOG2E, QS_MLA = 0.10206207261596575f * LOG2E;
constexpr int CW_TMO = 0, CW_CODE = 1, CW_BAR = 4096, CW_QUEUE = 8192  , CW_ECNT = 12288  , CW_MASKRDY = 16384  ;

constexpr int RING_BYTES = 131072, MISC_OFF = RING_BYTES + 320, LDS_BYTES = 147456;
constexpr int ROWTAB_OFF = RING_BYTES + 4096;
constexpr int LDSX_OFF = RING_BYTES + 1024;

#define RLX_AGENT __ATOMIC_RELAXED, __HIP_MEMORY_SCOPE_AGENT
DI unsigned f2bf(float f) { unsigned u = __builtin_bit_cast(unsigned, f); return (u + 0x7fffu + ((u >> 16) & 1u)) >> 16; }
DI unsigned pk2(float lo, float hi) { f32x2 v = {lo, hi}; bf16x2_t b = __builtin_convertvector(v, bf16x2_t); return __builtin_bit_cast(unsigned, b); }
DI float bf2f(unsigned short h) { return __builtin_bit_cast(float, (unsigned)h << 16); }
DI float wave_sum(float v) {
    v += __int_as_float(__builtin_amdgcn_update_dpp(0, __float_as_int(v), 0xB1, 0xf, 0xf, true));
    v += __int_as_float(__builtin_amdgcn_update_dpp(0, __float_as_int(v), 0x4E, 0xf, 0xf, true));
    v += __int_as_float(__builtin_amdgcn_update_dpp(0, __float_as_int(v), 0x141, 0xf, 0xf, true));
    v += __int_as_float(__builtin_amdgcn_update_dpp(0, __float_as_int(v), 0x140, 0xf, 0xf, true));
    v += __shfl_xor(v, 16); v += __shfl_xor(v, 32);
    return v;
}

#define XB_TMO      128
#define XB_XCNT(j)  (256  + 64 * (j))
#define XB_XSUB(j)  (1280 + 64 * (j))
#define XB_XGEN(j)  (2304 + 64 * (j))
#define XB_TOP      3328
#define XB_TOPGEN   3392
#define XCD_BAR_WORDS 3456
#define XB_SPIN_CAP (1u << 18)
DI unsigned xb_ld(unsigned* p)              { return __hip_atomic_load(p, __ATOMIC_RELAXED, __HIP_MEMORY_SCOPE_AGENT); }
DI unsigned xb_add(unsigned* p, unsigned v) { return __hip_atomic_fetch_add(p, v, __ATOMIC_RELAXED, __HIP_MEMORY_SCOPE_AGENT); }
DI unsigned xb_xcc_id() { return (unsigned)__builtin_amdgcn_s_getreg((3 << 11) | 20) & 0xFu; }
#define XB_SPIN(cond, bar) do { unsigned _sp = 0; while (cond) { __builtin_amdgcn_s_sleep(1); \
    if ((++_sp & 255u) == 0u) { if (xb_ld(&(bar)[XB_TMO])) break; if (_sp > XB_SPIN_CAP) { atomicAdd(&(bar)[XB_TMO], 1u); break; } } } } while (0)
struct XcdBarrier { unsigned* bar; unsigned x; volatile LAS unsigned* st; };
DI XcdBarrier xcd_barrier_post(unsigned* bar, volatile LAS unsigned* st) {
    XcdBarrier b; b.bar = bar; b.x = xb_xcc_id(); b.st = st;
    if (threadIdx.x == 0) (void)xb_add(&bar[XB_XCNT(b.x)], 1u);
    return b;
}
DI void xcd_barrier_complete(unsigned* bar, unsigned x, unsigned& nloc, unsigned& nx) {
    const unsigned G = gridDim.x * gridDim.y * gridDim.z;
    unsigned sum, cnt, mine, sp = 0u;
    for (;;) {
        sum = 0u; cnt = 0u; mine = 0u;
#pragma unroll
        for (unsigned j = 0; j < 16; ++j) { const unsigned c = xb_ld(&bar[XB_XCNT(j)]); sum += c; cnt += (c > 0u) ? 1u : 0u; mine = (j == x) ? c : mine; }
        if (sum == G) break;
        __builtin_amdgcn_s_sleep(1);
        if ((++sp & 255u) == 0u) { if (xb_ld(&bar[XB_TMO])) break; if (sp > XB_SPIN_CAP) { atomicAdd(&bar[XB_TMO], 1u); break; } }
    }
    nloc = mine > 0u ? mine : 1u; nx = cnt > 0u ? cnt : 1u;
}
DI void xcd_barrier(const XcdBarrier& b) {
    asm volatile("s_waitcnt vmcnt(0)" ::: "memory");
    __syncthreads();
    if (threadIdx.x == 0) {
        unsigned* bar = b.bar;
        __builtin_amdgcn_s_waitcnt(0);
        unsigned nloc = b.st[0], nx = b.st[1];
        if (nloc == 0u) { xcd_barrier_complete(bar, b.x, nloc, nx); b.st[0] = nloc; b.st[1] = nx; }
        const unsigned old = xb_add(&bar[XB_XSUB(b.x)], 1u);
        const unsigned gen = old / nloc;
        if (old + 1u == (gen + 1u) * nloc) {
            __builtin_amdgcn_fence(__ATOMIC_RELEASE, "agent");
            asm volatile("s_waitcnt vmcnt(0)" ::: "memory");
            const unsigned og = xb_add(&bar[XB_TOP], 1u);
            const unsigned tg = og / nx;
            if (og + 1u == (tg + 1u) * nx) xb_add(&bar[XB_TOPGEN], 1u);
            else XB_SPIN(xb_ld(&bar[XB_TOPGEN]) == tg, bar);
            __builtin_amdgcn_fence(__ATOMIC_ACQUIRE, "agent");
            xb_add(&bar[XB_XGEN(b.x)], 1u);
            asm volatile("s_waitcnt vmcnt(0)" ::: "memory");
        } else {
            XB_SPIN(xb_ld(&bar[XB_XGEN(b.x)]) == gen, bar);
            __builtin_amdgcn_fence(__ATOMIC_ACQUIRE, "agent");
            asm volatile("s_waitcnt vmcnt(0)" ::: "memory");
        }
    }
    __syncthreads();
}

namespace pg8 {
constexpr int BM = 256, BK = 64, HALF = 128, HTB = HALF * BK * 2, STAGE_BYTES = 8 * HTB, NXCD = 8, WGM = 8;
__host__ __device__ __forceinline__ int lds_byte(int r, int c) { const int st = (r >> 4) * 2 + (c >> 5), rr = r & 15, cc = c & 31, ob = rr * 64 + cc * 2; return st * 1024 + (ob ^ (((ob >> 9) & 1) << 5)); }
__host__ __device__ __forceinline__ void stage_rc(int b, int& R, int& C) { const int st = b / 1024, sb = b % 1024, swz = sb ^ (((sb >> 9) & 1) << 5); R = (st >> 1) * 16 + swz / 64; C = (st & 1) * 32 + (swz % 64) / 2; }
__host__ __device__ __forceinline__ int perm32(int rho) { const int n = rho >> 4, i = rho & 15; return 8 * (i >> 2) + 4 * n + (i & 3); }
struct Unit { int pm, pn; };
struct TileOrder {
    int nM, nN, nwg, G, c, pm0;
    DI void init(int nM_, int nN_, int G_, int c_, int pm0_) { nM = nM_; nN = nN_; nwg = nM * nN; G = G_; c = c_; pm0 = pm0_; }
    DI bool next(int i, Unit& u) const {
        const long L = (long)i * G + c; if (L >= nwg) return false;
        int wgid = (int)L; { const int q = nwg / NXCD, r = nwg % NXCD, xcd = wgid % NXCD, off = wgid / NXCD; wgid = (xcd < r ? xcd * (q + 1) : r * (q + 1) + (xcd - r) * q) + off; }
        const int nig = WGM * nN, gid = wgid / nig, fm = gid * WGM, gsz = (nM - fm) < WGM ? (nM - fm) : WGM;
        u.pm = pm0 + fm + ((wgid % nig) % gsz); u.pn = (wgid % nig) / gsz; return true;
    }
};
template <int MODE> struct AccT { typedef f32x4 type; };
template <> struct AccT<1> { typedef i32x4 type; };
template <int MODE, class Epi, class Sched, bool ALIGN_EPI>
DI void gemm_phase(LAS unsigned char* lds, const int KB, const Sched& S, const Epi& E) {
    typedef typename AccT<MODE>::type acc_t;
    constexpr bool GA = Sched::GATHER;
    int tid_ = threadIdx.x; asm volatile("" : "+v"(tid_));
    const int tid = tid_, wid = __builtin_amdgcn_readfirstlane(tid >> 6), lane = tid & 63, wr = wid >> 2, wc = wid & 3, fr = lane & 15, fq = lane >> 4;
    const int nt = KB / 128;
    unsigned cvo[2][2] = {{0u, 0u}, {0u, 0u}}, nvo[2][2] = {{0u, 0u}, {0u, 0u}};
    unsigned voA, voB;
    { int R, C; stage_rc(tid * 16, R, C); voA = (unsigned)R * S.lda2 + (unsigned)C * 2u; voB = (unsigned)(((R & ~31) + perm32(R & 31)) * KB) + (unsigned)C * 2u; }
    const size_t q64A = (size_t)64 * S.lda2, q64B = (size_t)64 * KB;
    const unsigned kstep = (unsigned)(BK * 2);
    const size_t hstepB = (size_t)HALF * KB;
    const unsigned ldsw = (unsigned)wid * 1024u;
    const int aoff = lds_byte(wr * 64 + fr, fq * 8), boff = lds_byte(wc * 32 + fr, fq * 8);
#define PG8_SA(b, h) (((b) * 2 + (h)) * HTB)
#define PG8_SB(b, h) ((4 + (b) * 2 + (h)) * HTB)
#define PG8_STAGEB(bufoff, gbase) do { \
        __builtin_amdgcn_global_load_lds((const unsigned*)((const char*)(gbase) + voB), (LAS unsigned*)(lds + (bufoff) + ldsw), 16, 0, 0); \
        __builtin_amdgcn_global_load_lds((const unsigned*)((const char*)(gbase) + q64B + voB), (LAS unsigned*)(lds + (bufoff) + ldsw + 8192), 16, 0, 0); } while (0)
#define PG8_STAGEA(bufoff, gbase, o0, o1) do { \
        __builtin_amdgcn_global_load_lds((const unsigned*)((const char*)(gbase) + (o0)), (LAS unsigned*)(lds + (bufoff) + ldsw), 16, 0, 0); \
        __builtin_amdgcn_global_load_lds((const unsigned*)((const char*)(gbase) + (o1)), (LAS unsigned*)(lds + (bufoff) + ldsw + 8192), 16, 0, 0); } while (0)
#define PG8_STAGEAH(bufoff, gbase, h) do { if (GA) PG8_STAGEA(bufoff, gbase, cvo[h][0], cvo[h][1]); else { \
        __builtin_amdgcn_global_load_lds((const unsigned*)((const char*)(gbase) + (size_t)((h) * 2) * q64A + voA), (LAS unsigned*)(lds + (bufoff) + ldsw), 16, 0, 0); \
        __builtin_amdgcn_global_load_lds((const unsigned*)((const char*)(gbase) + (size_t)((h) * 2 + 1) * q64A + voA), (LAS unsigned*)(lds + (bufoff) + ldsw + 8192), 16, 0, 0); } } while (0)
#define PG8_GOFF(dst, u) do { _Pragma("unroll") for (int _i = 0; _i < 2; ++_i) { int R_, C_; stage_rc(tid * 16 + _i * 8192, R_, C_); \
        dst[0][_i] = S.a_row_off(u, R_) + (unsigned)C_ * 2u; dst[1][_i] = S.a_row_off(u, R_ + HALF) + (unsigned)C_ * 2u; } } while (0)
#define PG8_LD8(p) __builtin_shufflevector(*(const LAS i32x4*)(p), *(const LAS i32x4*)((p) + 1024), 0, 1, 2, 3, 4, 5, 6, 7)
#define PG8_LDA(dst, b, h) do { _Pragma("unroll") for (int m = 0; m < 4; ++m) dst[m] = PG8_LD8(lds + PG8_SA(b, h) + aoff + m * 2048); } while (0)
#define PG8_LDB(dst, b, h) do { _Pragma("unroll") for (int n = 0; n < 2; ++n) dst[n] = PG8_LD8(lds + PG8_SB(b, h) + boff + n * 2048); } while (0)
#define PG8_LO(x) __builtin_shufflevector((x), (x), 0, 1, 2, 3)
#define PG8_HI(x) __builtin_shufflevector((x), (x), 4, 5, 6, 7)
#define PG8_MMA(ai, bj, At, Bt) do { __builtin_amdgcn_s_setprio(1); _Pragma("unroll") for (int m = 0; m < 4; ++m) _Pragma("unroll") for (int n = 0; n < 2; ++n) { \
        if constexpr (MODE == 0) { acc[ai][bj][m][n] = __builtin_amdgcn_mfma_f32_16x16x32_bf16(__builtin_bit_cast(bf16x8, PG8_LO(Bt[n])), __builtin_bit_cast(bf16x8, PG8_LO(At[m])), acc[ai][bj][m][n], 0, 0, 0); \
                                   acc[ai][bj][m][n] = __builtin_amdgcn_mfma_f32_16x16x32_bf16(__builtin_bit_cast(bf16x8, PG8_HI(Bt[n])), __builtin_bit_cast(bf16x8, PG8_HI(At[m])), acc[ai][bj][m][n], 0, 0, 0); } \
        else if constexpr (MODE == 1) { acc[ai][bj][m][n] = __builtin_amdgcn_mfma_i32_16x16x64_i8(PG8_LO(Bt[n]), PG8_LO(At[m]), acc[ai][bj][m][n], 0, 0, 0); \
                                        acc[ai][bj][m][n] = __builtin_amdgcn_mfma_i32_16x16x64_i8(PG8_HI(Bt[n]), PG8_HI(At[m]), acc[ai][bj][m][n], 0, 0, 0); } \
        else { asm volatile("v_mfma_scale_f32_16x16x128_f8f6f4 %0, %1, %2, %0, %3, %3 op_sel_hi:[0,0,0]" : "+v"(acc[ai][bj][m][n]) : "v"(Bt[n]), "v"(At[m]), "v"(0x7f7f7f7f)); } } __builtin_amdgcn_s_setprio(0); } while (0)
#define PG8_WAIT_V(n) asm volatile("s_waitcnt vmcnt(" #n ")" ::: "memory")
#define PG8_WAIT_L(n) asm volatile("s_waitcnt lgkmcnt(" #n ")" ::: "memory")
#define PG8_BAR __builtin_amdgcn_s_barrier()
#define PG8_SCHED __builtin_amdgcn_sched_barrier(0)
    Unit cur, nxt; int ui = 0;
    if (!S.next(0, cur)) return;
    LAS float* rtab = (LAS float*)(lds + ROWTAB_OFF);
    { typename Epi::Info inf0 = E.info_load(cur, tid); E.info_store(rtab, tid, inf0); }
    acc_t acc[2][2][4][2];
#pragma unroll
    for (int a = 0; a < 2; ++a)
#pragma unroll
        for (int b = 0; b < 2; ++b)
#pragma unroll
            for (int m = 0; m < 4; ++m)
#pragma unroll
                for (int n = 0; n < 2; ++n) acc[a][b][m][n] = (acc_t){0, 0, 0, 0};
    i32x8 At[4], B0[2], B1[2];
    if (GA) PG8_GOFF(cvo, cur);
    const char* cA = S.a_base(cur); const char* cB = S.b_base(cur);
    PG8_STAGEB(PG8_SB(0, 0), cB); PG8_STAGEB(PG8_SB(0, 1), cB + hstepB); PG8_STAGEAH(PG8_SA(0, 0), cA, 0); PG8_STAGEAH(PG8_SA(0, 1), cA, 1);
    if (wr == 1) PG8_BAR;
    PG8_WAIT_V(2); PG8_BAR;
    PG8_STAGEB(PG8_SB(1, 0), cB + kstep); PG8_STAGEAH(PG8_SA(1, 0), cA + kstep, 0); PG8_STAGEB(PG8_SB(1, 1), cB + hstepB + kstep);
    PG8_WAIT_V(6); PG8_BAR;
    for (;;) {
        const bool has_next = S.next(ui + 1, nxt);
        const char* nA = has_next ? S.a_base(nxt) : cA; const char* nB = has_next ? S.b_base(nxt) : cB;
        if (GA) { if (has_next) PG8_GOFF(nvo, nxt); else {
#pragma unroll
            for (int h = 0; h < 2; ++h)
#pragma unroll
                for (int i = 0; i < 2; ++i) nvo[h][i] = cvo[h][i]; } }
#pragma unroll 1
        for (int t = 0; t < nt; t += 2) {
            const bool last = (t == nt - 2);
            const char* a1 = cA + (size_t)(t + 1) * kstep;
            const char* a2 = last ? nA : cA + (size_t)(t + 2) * kstep; const char* b2 = last ? nB : cB + (size_t)(t + 2) * kstep;
            const char* a3 = a2 + kstep; const char* b3 = b2 + kstep;
            PG8_LDB(B0, 0, 0); PG8_LDB(B1, 0, 1); PG8_SCHED; PG8_LDA(At, 0, 0); PG8_STAGEAH(PG8_SA(1, 1), a1, 1);
            if (GA) { if (last) { cvo[0][0] = nvo[0][0]; cvo[0][1] = nvo[0][1]; cvo[1][0] = nvo[1][0]; cvo[1][1] = nvo[1][1]; } }
            PG8_WAIT_V(8); PG8_WAIT_L(0); PG8_BAR; PG8_MMA(0, 0, At, B0); PG8_MMA(0, 1, At, B1); PG8_BAR; PG8_SCHED;
            PG8_LDA(At, 0, 1); PG8_STAGEB(PG8_SB(0, 0), b2); PG8_STAGEB(PG8_SB(0, 1), b2 + hstepB); PG8_STAGEAH(PG8_SA(0, 0), a2, 0);
            PG8_WAIT_V(8); PG8_WAIT_L(0); PG8_BAR; PG8_MMA(1, 0, At, B0); PG8_MMA(1, 1, At, B1); PG8_BAR; PG8_SCHED;
            PG8_LDB(B0, 1, 0); PG8_LDB(B1, 1, 1); PG8_SCHED; PG8_LDA(At, 1, 0); PG8_STAGEAH(PG8_SA(0, 1), a2, 1);
            PG8_WAIT_V(8); PG8_WAIT_L(0); PG8_BAR; PG8_MMA(0, 0, At, B0); PG8_MMA(0, 1, At, B1); PG8_BAR; PG8_SCHED;
            PG8_LDA(At, 1, 1); PG8_STAGEB(PG8_SB(1, 0), b3); PG8_STAGEB(PG8_SB(1, 1), b3 + hstepB); PG8_STAGEAH(PG8_SA(1, 0), a3, 0);
            PG8_WAIT_V(8); PG8_WAIT_L(0); PG8_BAR; PG8_MMA(1, 0, At, B0); PG8_MMA(1, 1, At, B1); PG8_BAR; PG8_SCHED;
        }
        if constexpr (ALIGN_EPI) { if (wr == 0) PG8_BAR; }
        if constexpr (MODE == 2) asm volatile("s_nop 15\n\ts_nop 15" ::: "memory");
        typename Epi::Info ninf = E.info_load(has_next ? nxt : cur, tid);
        E(acc, cur, wr, wc, fr, fq, rtab + (ui & 1) * 512);
        if (!has_next) break;
        E.info_store(rtab + ((ui + 1) & 1) * 512, tid, ninf);
#pragma unroll
        for (int a = 0; a < 2; ++a)
#pragma unroll
            for (int b = 0; b < 2; ++b)
#pragma unroll
                for (int m = 0; m < 4; ++m)
#pragma unroll
                    for (int n = 0; n < 2; ++n) acc[a][b][m][n] = (acc_t){0, 0, 0, 0};
        cur = nxt; cA = nA; cB = nB; ++ui;
        if (GA) {
#pragma unroll
            for (int h = 0; h < 2; ++h)
#pragma unroll
                for (int i = 0; i < 2; ++i) cvo[h][i] = nvo[h][i]; }
        if constexpr (ALIGN_EPI) { if (wr == 1) PG8_BAR; }
    }
    PG8_WAIT_V(0);
    if constexpr (!ALIGN_EPI) { if (wr == 0) PG8_BAR; }
    PG8_BAR;
#undef PG8_SA
#undef PG8_SB
#undef PG8_STAGEA
#undef PG8_STAGEAH
#undef PG8_STAGEB
#undef PG8_GOFF
#undef PG8_LDA
#undef PG8_LD8
#undef PG8_LO
#undef PG8_HI
#undef PG8_LDB
#undef PG8_MMA
#undef PG8_WAIT_V
#undef PG8_WAIT_L
#undef PG8_BAR
#undef PG8_SCHED
}
}

struct SchedDense {
    static constexpr bool GATHER = false;
    pg8::TileOrder T; unsigned lda2; int arow0; const char* A; const char* Bt; size_t btile;
    DI bool next(int i, pg8::Unit& u) const { return T.next(i, u); }
    DI const char* a_base(const pg8::Unit& u) const { return A + (size_t)(u.pm * 256 - arow0) * lda2; }
    DI unsigned a_row_off(const pg8::Unit&, int) const { return 0u; }
    DI const char* b_base(const pg8::Unit& u) const { return Bt + (size_t)u.pn * btile; }
};
struct SchedMoeGU {
    static constexpr bool GATHER = true;
    pg8::TileOrder T; unsigned lda2; const char* A; const int* rowtok; const LAS int* tile_e; const char* Bt; size_t btile, estride;
    DI bool next(int i, pg8::Unit& u) const { return T.next(i, u); }
    DI const char* a_base(const pg8::Unit&) const { return A; }
    DI unsigned a_row_off(const pg8::Unit& u, int r) const { int t = rowtok[u.pm * 256 + r]; t = t < 0 ? 0 : t; return (unsigned)t * lda2; }
    DI const char* b_base(const pg8::Unit& u) const { return Bt + (size_t)(tile_e[u.pm] & 7) * estride + (size_t)u.pn * btile; }
};
struct SchedMoeD {
    static constexpr bool GATHER = false;
    pg8::TileOrder T; unsigned lda2; int arow0; const char* A; const LAS int* tile_e; const char* Bt; size_t btile, estride;
    DI bool next(int i, pg8::Unit& u) const { return T.next(i, u); }
    DI const char* a_base(const pg8::Unit& u) const { return A + (size_t)(u.pm * 256 - arow0) * lda2; }
    DI unsigned a_row_off(const pg8::Unit&, int) const { return 0u; }
    DI const char* b_base(const pg8::Unit& u) const { return Bt + (size_t)(tile_e[u.pm] & 7) * estride + (size_t)u.pn * btile; }
};

DI int perm64(int p) { if (p >= 16) return p; const int g = p >> 3, e = p & 7; return e < 4 ? 4 * g + e : 8 + 4 * g + (e - 4); }
DI int perm32r(int p) { const int g = p >> 3, e = p & 7; return e < 4 ? 4 * g + e : 16 + 4 * g + (e - 4); }
DI int win_src_col(int n) {
    if (n < 256) return ((n >> 6) << 6) + perm64(n & 63);
    if (n < 768) { const int q = n - 256; return 384 + ((q >> 6) << 6) + perm64(q & 63); }
    if (n < 1024) return 968 + (n - 768);
    if (n < 1280) return 1224 + (n - 1024);
    if (n < 1536) return 1480 + (n - 1280);
    if (n < 1792) return 1736 + (n - 1536);
    if (n < 1920) return 1992 + (n - 1792);
    if (n < 1984) return 256 + perm64(n - 1920);
    if (n < 2048) return 320 + (n - 1984);
    if (n < 2112) return 896 + perm64(n - 2048);
    if (n < 2144) return 2120 + perm32r(n - 2112);
    if (n < 2152) return 960 + (n - 2144);
    return -1;
}
DI int win_rope_off(int n) {
    if (n < 768) { const int p = n & 63; return p == 0 ? 0 : (p == 8 ? 4 : -1); }
    if (n < 1280) return (n & 31) == 0 ? 8 : -1;
    if (n >= 1920 && n < 1984) { const int p = n - 1920; return p == 0 ? 0 : (p == 8 ? 4 : -1); }
    if (n >= 2048 && n < 2112) { const int p = n - 2048; return p == 0 ? 0 : (p == 8 ? 4 : -1); }
    if (n >= 2112 && n < 2144) return 12 + 4 * ((n - 2112) >> 3);
    return -1;
}
DI int wuq_src_col(int n) { const int hh = n / 96, p = n % 96; return hh * 96 + (p < 64 ? p : 64 + perm32r(p - 64)); }
DI int wuq_rope_off(int n) { const int p = n % 96; return p >= 64 ? 12 + 4 * ((p - 64) >> 3) : -1; }

typedef const f32x4 (&AccRef)[2][2][4][2];
DI float sum16(const float* p) { const f32x4 a = *(const f32x4*)p, b = *(const f32x4*)(p + 4), c = *(const f32x4*)(p + 8), d = *(const f32x4*)(p + 12);
    return ((a[0] + a[1]) + (a[2] + a[3])) + ((b[0] + b[1]) + (b[2] + b[3])) + (((c[0] + c[1]) + (c[2] + c[3])) + ((d[0] + d[1]) + (d[2] + d[3]))); }
DI float sum4(const float* p) { const f32x4 a = *(const f32x4*)p; return (a[0] + a[1]) + (a[2] + a[3]); }
DI u32x4 pack8(const f32x4 v0, const f32x4 v1) { u32x4 w; w.x = pk2(v0[0], v0[1]); w.y = pk2(v0[2], v0[3]); w.z = pk2(v1[0], v1[1]); w.w = pk2(v1[2], v1[3]); return w; }
DI float dot4(const f32x4 a) { return (a[0] * a[0] + a[1] * a[1]) + (a[2] * a[2] + a[3] * a[3]); }

struct NoInfo { };
struct EpiIn {
    struct Info { float s; };
    bf16_t* P; const float* ssqA; const float* cs; float* ssqCQ; float* ssqCKV;
    DI Info info_load(const pg8::Unit& u, int tid) const { const float* p = ssqA + (size_t)(u.pm * 256 + (tid >> 1)) * 16 + 8 * (tid & 1); const f32x4 a = *(const f32x4*)p, b = *(const f32x4*)(p + 4);
        return Info{((a[0] + a[1]) + (a[2] + a[3])) + ((b[0] + b[1]) + (b[2] + b[3]))}; }
    DI void info_store(LAS float* tab, int tid, const Info& i) const { float s = i.s; s += __shfl_xor(s, 1); if (!(tid & 1)) tab[tid >> 1] = 1.0f / sqrtf(s * (1.0f / 1024.0f) + EPS); }
    DI void operator()(AccRef acc, const pg8::Unit& u, int wr, int wc, int fr, int fq, const LAS float* tab) const {
        const int colb = u.pn * 256 + wc * 32 + 8 * fq;
        int ro[2];
#pragma unroll
        for (int bj = 0; bj < 2; ++bj) ro[bj] = win_rope_off(colb + bj * 128);
        const bool sq_cq = (u.pn == 6), sq_ckv = (u.pn == 7);
        const float qsc = (u.pn == 0) ? QS_DSA : (u.pn == 3) ? QS_DIFF : 1.0f;
#pragma unroll
        for (int ai = 0; ai < 2; ++ai)
#pragma unroll
            for (int m = 0; m < 4; ++m) {
                int rr = ai * 128 + wr * 64 + m * 16 + fr; asm volatile("" : "+v"(rr));
                const int row = u.pm * 256 + rr;
                const float rstd = tab[rr];
                float sq = 0.f;
#pragma unroll
                for (int bj = 0; bj < 2; ++bj) {
                    f32x4 v0 = acc[ai][bj][m][0] * rstd, v1 = acc[ai][bj][m][1] * rstd;
                    if (ro[bj] >= 0) {
                        const f32x4 c4 = *(const f32x4*)(cs + (size_t)row * CSW + ro[bj]), s4 = *(const f32x4*)(cs + (size_t)row * CSW + NFREQ + ro[bj]);
                        const f32x4 n0 = v0 * c4 - v1 * s4, n1 = v1 * c4 + v0 * s4; v0 = n0; v1 = n1;
                    }
                    if (sq_cq || (sq_ckv && bj == 0)) sq += dot4(v0) + dot4(v1);
                    if (qsc != 1.0f) { v0 = v0 * qsc; v1 = v1 * qsc; }
                    const int col = colb + bj * 128;
                    if (col < PP) *(u32x4*)(P + (size_t)row * PP + col) = pack8(v0, v1);
                }
                if (sq_cq || sq_ckv) {
                    sq += __shfl_xor(sq, 16); sq += __shfl_xor(sq, 32);
                    if (fq == 0) { if (sq_cq) ssqCQ[(size_t)row * 4 + wc] = sq; else ssqCKV[(size_t)row * 4 + wc] = sq; }
                }
                asm volatile("" ::: "memory");
            }
    }
};
template <bool ROPE> struct EpiLat {
    struct Info { float s; };
    bf16_t* O; int ldc; const float* ssq4; float invn; const float* cs;
    DI Info info_load(const pg8::Unit& u, int tid) const { return Info{tid < 256 ? sum4(ssq4 + (size_t)(u.pm * 256 + tid) * 4) : 0.f}; }
    DI void info_store(LAS float* tab, int tid, const Info& i) const { if (tid < 256) tab[tid] = 1.0f / sqrtf(i.s * invn + EPS); }
    DI void operator()(AccRef acc, const pg8::Unit& u, int wr, int wc, int fr, int fq, const LAS float* tab) const {
        const int colb = u.pn * 256 + wc * 32 + 8 * fq;
        int ro[2] = {-1, -1};
        if (ROPE) {
#pragma unroll
            for (int bj = 0; bj < 2; ++bj) ro[bj] = wuq_rope_off(colb + bj * 128);
        }
#pragma unroll
        for (int am = 0; am < 4; ++am) {
          const int ai = am >> 1;
          f32x4 cc[2][2], ss[2][2];
#pragma unroll
          for (int mm = 0; mm < 2; ++mm) { const float* cb = cs + (size_t)(u.pm * 256 + ai * 128 + wr * 64 + (2 * (am & 1) + mm) * 16 + fr) * CSW;
#pragma unroll
              for (int bj = 0; bj < 2; ++bj) { cc[mm][bj] = (f32x4){0.f, 0.f, 0.f, 0.f}; ss[mm][bj] = cc[mm][bj]; if (ROPE && ro[bj] >= 0) { cc[mm][bj] = *(const f32x4*)(cb + ro[bj]); ss[mm][bj] = *(const f32x4*)(cb + NFREQ + ro[bj]); } } }
#pragma unroll
            for (int mm = 0; mm < 2; ++mm) {
                const int m = 2 * (am & 1) + mm;
                const int rr = ai * 128 + wr * 64 + m * 16 + fr, row = u.pm * 256 + rr;
                const float rstd = tab[rr];
#pragma unroll
                for (int bj = 0; bj < 2; ++bj) {
                    f32x4 v0 = acc[ai][bj][m][0] * rstd, v1 = acc[ai][bj][m][1] * rstd;
                    if (ROPE && ro[bj] >= 0) {
                        const f32x4 c4 = cc[mm][bj], s4 = ss[mm][bj];
                        const f32x4 n0 = v0 * c4 - v1 * s4, n1 = v1 * c4 + v0 * s4; v0 = n0; v1 = n1;
                    }
                    if (ROPE) { v0 = v0 * QS_MLA; v1 = v1 * QS_MLA; }
                    *(u32x4*)(O + (size_t)row * ldc + colb + bj * 128) = pack8(v0, v1);
                }
            }
            asm volatile("" ::: "memory");
        }
    }
};
DI f32x4 bf2lo(const unsigned a, const unsigned b) { return (f32x4){__uint_as_float(a << 16), __uint_as_float(a & 0xffff0000u), __uint_as_float(b << 16), __uint_as_float(b & 0xffff0000u)}; }
struct EpiResB {
    typedef NoInfo Info;
    bf16_t* h; float* ssq16; float ascale;
    DI Info info_load(const pg8::Unit&, int) const { return Info{}; }
    DI void info_store(LAS float*, int, const Info&) const {}
    DI void operator()(AccRef acc, const pg8::Unit& u, int wr, int wc, int fr, int fq, const LAS float*) const {
        const int colb = u.pn * 256 + wc * 32 + 8 * fq;
#pragma unroll
        for (int ai = 0; ai < 2; ++ai) {
            u32x4 hv[4][2];
#pragma unroll
            for (int m = 0; m < 4; ++m)
#pragma unroll
                for (int bj = 0; bj < 2; ++bj) hv[m][bj] = *(const u32x4*)(h + (size_t)(u.pm * 256 + ai * 128 + wr * 64 + m * 16 + fr) * DM + colb + bj * 128);
#pragma unroll
            for (int m = 0; m < 4; ++m) {
                const int row = u.pm * 256 + ai * 128 + wr * 64 + m * 16 + fr;
                float sq = 0.f;
#pragma unroll
                for (int bj = 0; bj < 2; ++bj) {
                    const size_t off = (size_t)row * DM + colb + bj * 128;
                    const f32x4 v0 = bf2lo(hv[m][bj].x, hv[m][bj].y) + acc[ai][bj][m][0] * ascale, v1 = bf2lo(hv[m][bj].z, hv[m][bj].w) + acc[ai][bj][m][1] * ascale;
                    *(u32x4*)(h + off) = pack8(v0, v1);
                    if (ssq16) sq += dot4(v0) + dot4(v1);
                }
                if (ssq16) { sq += __shfl_xor(sq, 16); sq += __shfl_xor(sq, 32);
                    if (fq == 0) ssq16[(size_t)row * 16 + u.pn * 4 + wc] = sq; }
            }
            asm volatile("" ::: "memory");
        }
    }
};
struct EpiRes {
    typedef NoInfo Info;
    const float* hprev; float* hout; bf16_t* hb; float* ssq16; float ascale;
    DI Info info_load(const pg8::Unit&, int) const { return Info{}; }
    DI void info_store(LAS float*, int, const Info&) const {}
    DI void operator()(AccRef acc, const pg8::Unit& u, int wr, int wc, int fr, int fq, const LAS float*) const {
        const int colb = u.pn * 256 + wc * 32 + 8 * fq;
#pragma unroll
        for (int ai = 0; ai < 2; ++ai)
#pragma unroll
            for (int m = 0; m < 4; ++m) {
                const int row = u.pm * 256 + ai * 128 + wr * 64 + m * 16 + fr;
                float sq = 0.f;
#pragma unroll
                for (int bj = 0; bj < 2; ++bj) {
                    const size_t off = (size_t)row * DM + colb + bj * 128;
                    const f32x4 v0 = *(const f32x4*)(hprev + off) + acc[ai][bj][m][0] * ascale, v1 = *(const f32x4*)(hprev + off + 4) + acc[ai][bj][m][1] * ascale;
                    *(f32x4*)(hout + off) = v0; *(f32x4*)(hout + off + 4) = v1;
                    if (hb) { *(u32x4*)(hb + off) = pack8(v0, v1); sq += dot4(v0) + dot4(v1); }
                }
                if (hb) { sq += __shfl_xor(sq, 16); sq += __shfl_xor(sq, 32);
                    if (fq == 0) ssq16[(size_t)row * 16 + u.pn * 4 + wc] = sq; }
                if (m == 3) asm volatile("" ::: "memory");
            }
    }
};
DI float silu_mul(float g, float uu) { const float e = __builtin_amdgcn_exp2f(-1.4426950408889634f * g); return g * uu * __builtin_amdgcn_rcpf(1.0f + e); }
DI f32x2 silu_mul_pk(f32x2 g, f32x2 uu, float sc) { const f32x2 t = g * (-1.4426950408889634f); f32x2 e; e.x = __builtin_amdgcn_exp2f(t.x); e.y = __builtin_amdgcn_exp2f(t.y);
    const f32x2 d = e + 1.0f; f32x2 rc; rc.x = __builtin_amdgcn_rcpf(d.x); rc.y = __builtin_amdgcn_rcpf(d.y); return (g * rc) * (uu * sc); }
DI unsigned pk4_fp8(float a, float b, float c, float d) {
    a = __builtin_amdgcn_fmed3f(a, -448.f, 448.f); b = __builtin_amdgcn_fmed3f(b, -448.f, 448.f); c = __builtin_amdgcn_fmed3f(c, -448.f, 448.f); d = __builtin_amdgcn_fmed3f(d, -448.f, 448.f);
    int w = 0; w = __builtin_amdgcn_cvt_pk_fp8_f32(a, b, w, false); w = __builtin_amdgcn_cvt_pk_fp8_f32(c, d, w, true); return (unsigned)w; }
typedef const i32x4 (&AccRefI)[2][2][4][2];
template <bool MOE> struct EpiGU8 {
    struct Info { float r; };
    unsigned char* act; const float* ra; const float* sb; const int* rowtok; const LAS int* tile_e;
    DI Info info_load(const pg8::Unit& u, int tid) const { float r = 0.f; if (tid < 256) { int t = u.pm * 256 + tid; if (MOE) { t = rowtok[t]; t = t < 0 ? 0 : t; } r = ra[t]; } return Info{r}; }
    DI void info_store(LAS float* tab, int tid, const Info& i) const { if (tid < 256) tab[tid] = i.r; }
    DI void operator()(AccRefI acc, const pg8::Unit& u, int wr, int wc, int fr, int fq, const LAS float* tab) const {
        const int colb = u.pn * 128 + wc * 32 + 8 * fq;
        const float* sbp = sb + (MOE ? (size_t)(tile_e[u.pm] & 7) * (2 * DFF) : 0) + u.pn * 256 + wc * 32 + 8 * fq;
        const f32x4 sg0 = *(const f32x4*)sbp, sg1 = *(const f32x4*)(sbp + 4), su0 = *(const f32x4*)(sbp + 128), su1 = *(const f32x4*)(sbp + 132);
#pragma unroll
        for (int ai = 0; ai < 2; ++ai)
#pragma unroll
            for (int m = 0; m < 4; ++m) {
                const int rr = ai * 128 + wr * 64 + m * 16 + fr, row = u.pm * 256 + rr;
                const float r = tab[rr];
                const f32x4 g0 = __builtin_convertvector(acc[ai][0][m][0], f32x4) * sg0 * r, g1 = __builtin_convertvector(acc[ai][0][m][1], f32x4) * sg1 * r;
                const f32x4 u0 = __builtin_convertvector(acc[ai][1][m][0], f32x4) * su0, u1 = __builtin_convertvector(acc[ai][1][m][1], f32x4) * su1;
                const float rs = r * ACT_SCALE;
                const f32x2 a01 = silu_mul_pk((f32x2){g0[0], g0[1]}, (f32x2){u0[0], u0[1]}, rs), a23 = silu_mul_pk((f32x2){g0[2], g0[3]}, (f32x2){u0[2], u0[3]}, rs);
                const f32x2 a45 = silu_mul_pk((f32x2){g1[0], g1[1]}, (f32x2){u1[0], u1[1]}, rs), a67 = silu_mul_pk((f32x2){g1[2], g1[3]}, (f32x2){u1[2], u1[3]}, rs);
                u32x2 w; w.x = pk4_fp8(a01.x, a01.y, a23.x, a23.y); w.y = pk4_fp8(a45.x, a45.y, a67.x, a67.y);
                *(u32x2*)(act + (size_t)row * DFF + colb) = w;
            }
    }
};
struct EpiDownMoe {
    struct Info { int t; float g; };
    bf16_t* hout; bf16_t* y2; const int* rowtok; const float* rowgate; const LAS int* tile_e; float ascale;
    DI Info info_load(const pg8::Unit& u, int tid) const { Info i{-1, 0.f}; if (tid < 256) { i.t = rowtok[u.pm * 256 + tid]; i.g = rowgate[u.pm * 256 + tid]; } return i; }
    DI void info_store(LAS float* tab, int tid, const Info& i) const { if (tid < 256) { tab[tid] = __int_as_float(i.t); tab[256 + tid] = i.g * ascale; } }
    DI void operator()(AccRef acc, const pg8::Unit& u, int wr, int wc, int fr, int fq, const LAS float* tab) const {
        const int colb = u.pn * 256 + wc * 32 + 8 * fq; const bool second = tile_e[u.pm] >= 8;
#pragma unroll
        for (int ai = 0; ai < 2; ++ai) {
            int tk[4]; float gk[4]; u32x4 hv[4][2];
#pragma unroll
            for (int m = 0; m < 4; ++m) { const int rr = ai * 128 + wr * 64 + m * 16 + fr; tk[m] = __float_as_int(tab[rr]); gk[m] = tab[256 + rr];
#pragma unroll
                for (int bj = 0; bj < 2; ++bj) { hv[m][bj] = (u32x4){0u, 0u, 0u, 0u}; if (!second && tk[m] >= 0) hv[m][bj] = *(const u32x4*)(hout + (size_t)tk[m] * DM + colb + bj * 128); } }
#pragma unroll
            for (int m = 0; m < 4; ++m) {
                const int t = tk[m]; const float gt = gk[m];
                if (t >= 0) {
#pragma unroll
                    for (int bj = 0; bj < 2; ++bj) {
                        const size_t off = (size_t)t * DM + colb + bj * 128;
                        f32x4 v0 = acc[ai][bj][m][0] * gt, v1 = acc[ai][bj][m][1] * gt;
                        if (second) { if (ascale != 0.f) *(u32x4*)(y2 + off) = pack8(v0, v1); }
                        else { v0 += bf2lo(hv[m][bj].x, hv[m][bj].y); v1 += bf2lo(hv[m][bj].z, hv[m][bj].w); *(u32x4*)(hout + off) = pack8(v0, v1); }
                    }
                }
            }
            asm volatile("" ::: "memory");
        }
    }
};

#define MFMA32(a, b, c) __builtin_amdgcn_mfma_f32_32x32x16_bf16((a), (b), (c), 0, 0, 0)
DI int crow(int r, int hi) { return (r & 3) + 8 * (r >> 2) + 4 * hi; }
DI float max3f(float a, float b, float c) { float r; asm("v_max3_f32 %0, %1, %2, %3" : "=v"(r) : "v"(a), "v"(b), "v"(c)); return r; }
DI float max2f(float a, float b) { float r; asm("v_max_f32_e32 %0, %1, %2" : "=v"(r) : "v"(a), "v"(b)); return r; }
DI unsigned bfi32(unsigned m, unsigned a, unsigned b) { unsigned r; asm("v_bfi_b32 %0, %1, %2, %3" : "=v"(r) : "v"(m), "v"(a), "v"(b)); return r; }
DI float hswap_max(float m) { auto rr = __builtin_amdgcn_permlane32_swap(__float_as_uint(m), __float_as_uint(m), false, false); return fmaxf(__uint_as_float(rr[0]), __uint_as_float(rr[1])); }
DI float hswap_sum(float m) { auto rr = __builtin_amdgcn_permlane32_swap(__float_as_uint(m), __float_as_uint(m), false, false); return __uint_as_float(rr[0]) + __uint_as_float(rr[1]); }
DI s16x4 vtr(const LAS unsigned char* p) { return __builtin_bit_cast(s16x4, __builtin_amdgcn_ds_read_tr16_b64_v4i16((LAS s16x4*)p)); }

template <int TYPE>
DI void attn_unit(LAS unsigned char* lds, const bf16_t* __restrict__ P, const bf16_t* __restrict__ QC, const bf16_t* __restrict__ KV, const unsigned* __restrict__ MASK, bf16_t* __restrict__ O,
                  const int b, const int h, const int qb, const float* __restrict__ subln, const float lam, const float outscale) {
    constexpr int KD = (TYPE == 0) ? 96 : 64;
    constexpr int DPM = (TYPE == 1) ? 32 : KD;
    constexpr int KST = DPM / 16;
    constexpr int KP = KD * 2 + 16;
    constexpr int NKC = KD / 8;
    constexpr int KBYTES = 64 * KP, BUFSZ = KBYTES + 8192, OST = 2 * BUFSZ, XCH = OST + 8 * (32 * 144);
    int tid_ = threadIdx.x; asm volatile("" : "+v"(tid_));
    const int tid = tid_, lane = tid & 63, r32 = lane & 31, hi = lane >> 5; const int w = __builtin_amdgcn_readfirstlane(tid >> 6);
    const int rowb = b * SEQ;
    int qrow, head, ntiles, wtiles, dimoff = 0;
    if (TYPE == 2) { qrow = rowb + 64 * qb + 32 * (w & 1) + r32; head = w >> 1; ntiles = qb + 1; wtiles = qb + 1; }
    else if (TYPE == 1) { qrow = rowb + 128 * qb + 32 * (w & 3) + r32; head = h; ntiles = 2 * qb + 2; wtiles = 2 * qb + ((w & 3) >> 1) + 1; dimoff = 32 * (w >> 2); }
    else { qrow = rowb + 256 * qb + 32 * w + r32; head = h; ntiles = 4 * qb + 4; wtiles = 4 * qb + (w >> 1) + 1; }
    bf16x8 qf[KST];
    {
        const bf16_t* qp = (TYPE == 0) ? QC + (size_t)qrow * 768 + head * 96 : (TYPE == 1) ? P + (size_t)qrow * PP + TQB + head * 64 + dimoff : P + (size_t)qrow * PP + TQA + head * 64;
#pragma unroll
        for (int ks = 0; ks < KST; ++ks) qf[ks] = *(const bf16x8*)(qp + 16 * ks + 8 * hi);
    }
    const int kkey0 = tid / NKC, kck0 = tid % NKC, kkey1 = (tid + 512) / NKC, kck1 = (tid + 512) % NKC;
    const bool k2nd = (TYPE == 0) && (tid < 256);
    const int vcl = tid & 3, vkey = (tid >> 2) & 63, vd0 = tid >> 8;
    auto ksrc = [&](int j, int key, int ck) -> const bf16_t* {
        const size_t kr = (size_t)(rowb + 64 * j + key);
        if (TYPE == 0) return ck < 8 ? KV + kr * 1024 + head * 128 + 8 * ck : P + kr * PP + TKR + 8 * (ck - 8);
        if (TYPE == 1) return P + kr * PP + TKB + head * 64 + 8 * ck;
        return P + kr * PP + TKA + 8 * ck;
    };
    auto vsrc = [&](int j) -> const bf16_t* {
        const size_t kr = (size_t)(rowb + 64 * j + vkey); const int d = 32 * vd0 + 8 * vcl;
        if (TYPE == 0) return KV + kr * 1024 + head * 128 + 64 + d;
        if (TYPE == 1) return P + kr * PP + TVB + head * 64 + d;
        return P + kr * PP + TVA + d;
    };
    u32x4 sk0, sk1 = (u32x4){0u, 0u, 0u, 0u}, sv;
#define ATT_LOAD(j) do { sk0 = *(const u32x4*)ksrc((j), kkey0, kck0); if (k2nd) sk1 = *(const u32x4*)ksrc((j), kkey1, kck1); sv = *(const u32x4*)vsrc(j); } while (0)
#define ATT_STORE(buf) do { LAS unsigned char* kb_ = lds + (buf) * BUFSZ; *(LAS u32x4*)(kb_ + kkey0 * KP + kck0 * 16) = sk0; if (k2nd) *(LAS u32x4*)(kb_ + kkey1 * KP + kck1 * 16) = sk1; \
        *(LAS u32x4*)(kb_ + KBYTES + tid * 16) = sv; } while (0)
    f32x2 lrA = (f32x2){0.f, 0.f}, lrB = (f32x2){0.f, 0.f}; f32x16 o[2], negm;
#pragma unroll
    for (int r = 0; r < 16; ++r) { negm[r] = 0.f; o[0][r] = 0.f; o[1][r] = 0.f; }
    ATT_LOAD(0); ATT_STORE(0);
    if (ntiles > 1) ATT_LOAD(1);
    asm volatile("s_waitcnt lgkmcnt(0)\n\ts_barrier" ::: "memory");
    const int voff = ((lane >> 4) & 1) * 32 + (lane & 3) * 8 + (4 * hi + ((lane & 15) >> 2)) * 64;
    u32x2 mwn = (u32x2){0xffffffffu, 0xffffffffu};
    const bool allsel = (TYPE == 2) && (qb < 4);
    if (TYPE == 2 && !allsel) mwn = *(const u32x2*)(MASK + (size_t)qrow * 64);
    for (int j = 0; j < ntiles; ++j) {
        const LAS unsigned char* Kb = lds + (j & 1) * BUFSZ; const LAS unsigned char* Vb = Kb + KBYTES;
        if (j < wtiles) {
            unsigned mw0 = 0xffffffffu, mw1 = 0xffffffffu;
            if (TYPE == 2) { mw0 = mwn.x >> (4 * hi); mw1 = mwn.y >> (4 * hi); if (!allsel && j + 1 < wtiles) mwn = *(const u32x2*)(MASK + (size_t)qrow * 64 + 2 * (j + 1)); }
            auto qk = [&](f32x16& s0, f32x16& s1) {
                const bf16x8 k0 = *(const LAS bf16x8*)(Kb + r32 * KP + (dimoff + 8 * hi) * 2);
                const bf16x8 k1 = *(const LAS bf16x8*)(Kb + (32 + r32) * KP + (dimoff + 8 * hi) * 2);
                if (TYPE == 2) {
                    f32x16 c0, c1; const unsigned nb = __float_as_uint(negm[0]), ninf = 0xff800000u;
#pragma unroll
                    for (int r = 0; r < 16; ++r) { const unsigned pos = (r & 3) + 8 * (r >> 2);
                        const unsigned t0 = (unsigned)__builtin_amdgcn_sbfe((int)mw0, pos, 1u), t1 = (unsigned)__builtin_amdgcn_sbfe((int)mw1, pos, 1u);
                        c0[r] = __uint_as_float(bfi32(t0, nb, ninf)); c1[r] = __uint_as_float(bfi32(t1, nb, ninf)); }
                    s0 = MFMA32(k0, qf[0], c0); s1 = MFMA32(k1, qf[0], c1);
                } else {
                    asm("v_mfma_f32_32x32x16_bf16 %0, %1, %2, %3" : "=&v"(s0) : "v"(k0), "v"(qf[0]), "v"(negm));
                    asm("v_mfma_f32_32x32x16_bf16 %0, %1, %2, %3" : "=&v"(s1) : "v"(k1), "v"(qf[0]), "v"(negm));
                }
#pragma unroll
                for (int ks = 1; ks < KST; ++ks) {
                    const bf16x8 ka = *(const LAS bf16x8*)(Kb + r32 * KP + (dimoff + 16 * ks + 8 * hi) * 2);
                    const bf16x8 kb = *(const LAS bf16x8*)(Kb + (32 + r32) * KP + (dimoff + 16 * ks + 8 * hi) * 2);
                    s0 = MFMA32(ka, qf[ks], s0); s1 = MFMA32(kb, qf[ks], s1);
                }
            };
            f32x16 s0, s1; qk(s0, s1);
            float r0, r1, r2, r3;
#pragma unroll
            for (int r = 0; r < 16; r += 2) {
                s0[r] = __builtin_amdgcn_exp2f(s0[r]); s0[r + 1] = __builtin_amdgcn_exp2f(s0[r + 1]); s1[r] = __builtin_amdgcn_exp2f(s1[r]); s1[r + 1] = __builtin_amdgcn_exp2f(s1[r + 1]);
                if (r == 2) asm("s_nop 0\n\tv_add_f32_e32 %0, %4, %8\n\tv_add_f32_e32 %1, %5, %9\n\tv_add_f32_e32 %2, %6, %10\n\tv_add_f32_e32 %3, %7, %11"
                                : "=&v"(r0), "=&v"(r1), "=&v"(r2), "=&v"(r3) : "v"(s0[0]), "v"(s0[1]), "v"(s1[0]), "v"(s1[1]), "v"(s0[2]), "v"(s0[3]), "v"(s1[2]), "v"(s1[3]));
                if (r > 2) asm("s_nop 0\n\tv_add_f32_e32 %0, %4, %0\n\tv_add_f32_e32 %1, %5, %1\n\tv_add_f32_e32 %2, %6, %2\n\tv_add_f32_e32 %3, %7, %3"
                               : "+v"(r0), "+v"(r1), "+v"(r2), "+v"(r3) : "v"(s0[r]), "v"(s0[r + 1]), "v"(s1[r]), "v"(s1[r + 1]));
            }
            if (__any(!(max2f(max3f(r0, r1, r2), r3) <= 65536.0f))) {
                qk(s0, s1);
                asm volatile("s_nop 11" : "+v"(s0), "+v"(s1));
                float mxa = max3f(s0[0], s0[1], s1[0]), mxb = max3f(s0[2], s0[3], s1[1]); mxa = max3f(mxa, s1[2], s1[3]);
#pragma unroll
                for (int r = 4; r < 16; r += 4) { mxa = max3f(mxa, s0[r], s0[r + 1]); mxb = max3f(mxb, s0[r + 2], s0[r + 3]); mxa = max3f(mxa, s1[r], s1[r + 1]); mxb = max3f(mxb, s1[r + 2], s1[r + 3]); }
                float mx = max2f(mxa, mxb);
                { auto rr = __builtin_amdgcn_permlane32_swap(__float_as_uint(mx), __float_as_uint(mx), false, false); mx = max2f(__uint_as_float(rr[0]), __uint_as_float(rr[1])); }
                const unsigned dlb = __float_as_uint(fmaxf(mx, 0.f)) & 0xffff0000u;
                const float dl = __uint_as_float(dlb), f = __builtin_amdgcn_exp2f(-dl);
                lrA *= f; lrB *= f;
                const unsigned sel = hi ? 0u : 0xffffffffu;
                const u32x4 aw = (u32x4){0x3f80u & sel, 0u, 0u, 0u}, bw = (u32x4){((dlb >> 16) | 0x8000u) & sel, 0u, 0u, 0u};
                negm = MFMA32(__builtin_bit_cast(bf16x8, aw), __builtin_bit_cast(bf16x8, bw), negm);
                float q0 = 0.f, q1 = 0.f, q2 = 0.f, q3 = 0.f;
#pragma unroll
                for (int r = 0; r < 16; r += 2) {
                    o[0][r] *= f; o[0][r + 1] *= f; o[1][r] *= f; o[1][r + 1] *= f;
                    s0[r] = __builtin_amdgcn_exp2f(s0[r] - dl); s0[r + 1] = __builtin_amdgcn_exp2f(s0[r + 1] - dl); s1[r] = __builtin_amdgcn_exp2f(s1[r] - dl); s1[r + 1] = __builtin_amdgcn_exp2f(s1[r + 1] - dl);
                    q0 += s0[r]; q1 += s0[r + 1]; q2 += s1[r]; q3 += s1[r + 1];
                }
                r0 = q0; r1 = q1; r2 = q2; r3 = q3;
            }
            lrA[0] += r0; lrA[1] += r1; lrB[0] += r2; lrB[1] += r3;
#pragma unroll
            for (int ks4 = 0; ks4 < 4; ++ks4) {
                u32x4 pw;
                if (ks4 == 0)      { pw.x = pk2(s0[0], s0[1]);  pw.y = pk2(s0[2], s0[3]);   pw.z = pk2(s0[4], s0[5]);   pw.w = pk2(s0[6], s0[7]); }
                else if (ks4 == 1) { pw.x = pk2(s0[8], s0[9]);  pw.y = pk2(s0[10], s0[11]); pw.z = pk2(s0[12], s0[13]); pw.w = pk2(s0[14], s0[15]); }
                else if (ks4 == 2) { pw.x = pk2(s1[0], s1[1]);  pw.y = pk2(s1[2], s1[3]);   pw.z = pk2(s1[4], s1[5]);   pw.w = pk2(s1[6], s1[7]); }
                else               { pw.x = pk2(s1[8], s1[9]);  pw.y = pk2(s1[10], s1[11]); pw.z = pk2(s1[12], s1[13]); pw.w = pk2(s1[14], s1[15]); }
                const bf16x8 pb = __builtin_bit_cast(bf16x8, pw);
#pragma unroll
                for (int d0 = 0; d0 < 2; ++d0) {
                    const s16x4 lo = vtr(Vb + voff + d0 * 4096 + ks4 * 1024), hh = vtr(Vb + voff + d0 * 4096 + ks4 * 1024 + 512);
                    const bf16x8 vf = (bf16x8){lo[0], lo[1], lo[2], lo[3], hh[0], hh[1], hh[2], hh[3]};
                    o[d0] = MFMA32(vf, pb, o[d0]);
                }
            }
        }
        if (j + 1 < ntiles) { ATT_STORE((j + 1) & 1); if (j + 2 < ntiles) ATT_LOAD(j + 2); }
        asm volatile("s_waitcnt lgkmcnt(0)\n\ts_barrier" ::: "memory");
    }
#undef ATT_LOAD
#undef ATT_STORE
    float res[2][16];
    {
        const float i0 = ((TYPE == 1 && w >= 4) ? lam : 1.0f) / hswap_sum((lrA[0] + lrA[1]) + (lrB[0] + lrB[1]));
#pragma unroll
        for (int d0 = 0; d0 < 2; ++d0)
#pragma unroll
            for (int r = 0; r < 16; ++r) res[d0][r] = o[d0][r] * i0;
    }
    if (TYPE == 1) {
        LAS float* xch = (LAS float*)(lds + XCH) + (w & 3) * 2048;
        if (w >= 4) {
#pragma unroll
            for (int d0 = 0; d0 < 2; ++d0)
#pragma unroll
                for (int r = 0; r < 16; ++r) xch[(d0 * 16 + r) * 64 + lane] = res[d0][r];
        }
        __syncthreads();
        if (w < 4) {
            float sq = 0.f;
#pragma unroll
            for (int d0 = 0; d0 < 2; ++d0)
#pragma unroll
                for (int r = 0; r < 16; ++r) { const float v = res[d0][r] - xch[(d0 * 16 + r) * 64 + lane]; res[d0][r] = v; sq += v * v; }
            sq = hswap_sum(sq);
            const float rstd = outscale / sqrtf(sq * (1.0f / 64.0f) + EPS);
#pragma unroll
            for (int d0 = 0; d0 < 2; ++d0)
#pragma unroll
                for (int r = 0; r < 16; ++r) res[d0][r] *= rstd * subln[32 * d0 + crow(r, hi)];
        }
    }
    if (TYPE != 1 || w < 4) {
        LAS unsigned char* stg = lds + OST + w * (32 * 144);
#pragma unroll
        for (int d0 = 0; d0 < 2; ++d0)
#pragma unroll
            for (int r = 0; r < 16; r += 2) *(LAS unsigned*)(stg + r32 * 144 + (32 * d0 + crow(r, hi)) * 2) = pk2(res[d0][r], res[d0][r + 1]);
        asm volatile("s_waitcnt lgkmcnt(0)" ::: "memory");
        const int ocol = (TYPE == 0) ? 512 + head * 64 : (TYPE == 1) ? 256 + head * 64 : head * 64;
        const int orow0 = qrow - r32;
#pragma unroll
        for (int i = 0; i < 4; ++i) { const int row = i * 8 + (lane >> 3), ch = lane & 7;
            const u32x4 v = *(const LAS u32x4*)(stg + row * 144 + ch * 16);
            *(u32x4*)(O + (size_t)(orow0 + row) * DM + ocol + ch * 8) = v; }
    }
    __syncthreads();
}

#define MFMA16(a, b, c) __builtin_amdgcn_mfma_f32_16x16x32_bf16((a), (b), (c), 0, 0, 0)
DI unsigned f2ord(float f) { const unsigned u = __float_as_uint(f); return (u & 0x80000000u) ? ~u : (u | 0x80000000u); }
DI float ord2f(unsigned u) { return __uint_as_float((u & 0x80000000u) ? (u & 0x7fffffffu) : ~u); }
constexpr int IDX_TOPK = 256;
DI void cnt4(unsigned& cnt, const f32x4 e, const float mid) {
    unsigned long long m0, m1, m2;
    asm("v_cmp_ge_f32_e64 %1, %4, %8\n\t"
        "v_cmp_ge_f32_e64 %2, %5, %8\n\t"
        "v_cmp_ge_f32_e64 %3, %6, %8\n\t"
        "v_cmp_ge_f32_e32 vcc, %7, %8\n\t"
        "v_addc_co_u32_e64 %0, %1, 0, %0, %1\n\t"
        "v_addc_co_u32_e64 %0, %2, 0, %0, %2\n\t"
        "v_addc_co_u32_e64 %0, %3, 0, %0, %3\n\t"
        "v_addc_co_u32_e32 %0, vcc, 0, %0, vcc"
        : "+v"(cnt), "=&s"(m0), "=&s"(m1), "=&s"(m2) : "v"(e[0]), "v"(e[1]), "v"(e[2]), "v"(e[3]), "v"(mid) : "vcc");
}
DI void idx_unit(LAS unsigned char* lds, const bf16_t* __restrict__ P, unsigned* __restrict__ MASK, const int b, const int g16, unsigned* __restrict__ rdy) {
    int tid_ = threadIdx.x; asm volatile("" : "+v"(tid_));
    const int tid = tid_, lane = tid & 63, q = lane & 15, g = lane >> 4; const int w = __builtin_amdgcn_readfirstlane(tid >> 6);
    const int c = g16 >> 2, NT = 4 * (c + 1);
    const int row0 = b * SEQ + 16 * g16;
    if (c < 4) {
        for (int i = tid; i < 16 * 64; i += 512) { const int qq = i >> 6, wd = i & 63; MASK[(size_t)(row0 + qq) * 64 + wd] = (wd < 2 * (c + 1)) ? 0xffffffffu : 0u; }
        return;
    }
    constexpr int IDXM = 0;
    LAS unsigned short* lmask = (LAS unsigned short*)(lds + IDXM);
    LAS unsigned short* leq = (LAS unsigned short*)(lds + IDXM + 4096);
    LAS float* redf = (LAS float*)(lds + IDXM + 8192);
    LAS unsigned* cbuf = (LAS unsigned*)(lds + IDXM + 8192 + 1024);
    LAS int* needs = (LAS int*)(lds + IDXM + 8192 + 2048);
    LAS unsigned* ccnt = (LAS unsigned*)(lds + IDXM + 8192 + 3072 + 2048);
    if (tid < 16) ccnt[tid] = 0u;
    for (int i = tid; i < 2048; i += 512) ((LAS unsigned*)(lds + IDXM))[i] = 0u;
    bf16x8 qf[8][2]; float wq[8];
    {
        const bf16_t* qp = P + (size_t)(row0 + q) * PP;
#pragma unroll
        for (int hd = 0; hd < 8; ++hd)
#pragma unroll
            for (int ks = 0; ks < 2; ++ks) qf[hd][ks] = *(const bf16x8*)(qp + TQI + hd * 64 + 32 * ks + 8 * g);
        const u32x4 wv = *(const u32x4*)(qp + TWI);
#pragma unroll
        for (int i = 0; i < 4; ++i) { wq[2 * i] = __uint_as_float(wv[i] << 16); wq[2 * i + 1] = __uint_as_float(wv[i] & 0xffff0000u); }
    }
    f32x4 sc[16];
    float vmin = INFINITY, vmax = -INFINITY, sm1 = 0.f, sm2 = 0.f;
    const int ntw = (NT - w + 7) >> 3;
    const bf16_t* kbase = P + (size_t)(b * SEQ + q) * PP + TKI + 8 * g;
    bf16x8 kA0, kA1, kB0, kB1;
    kA0 = *(const bf16x8*)(kbase + (size_t)(16 * w) * PP); kA1 = *(const bf16x8*)(kbase + (size_t)(16 * w) * PP + 32);
    kB0 = kA0; kB1 = kA1;
    if (ntw > 1) { kB0 = *(const bf16x8*)(kbase + (size_t)(16 * (w + 8)) * PP); kB1 = *(const bf16x8*)(kbase + (size_t)(16 * (w + 8)) * PP + 32); }
#pragma unroll
    for (int i = 0; i < 16; ++i) {
        if (i < ntw) {
            const bf16x8 k0 = kA0, k1 = kA1;
            kA0 = kB0; kA1 = kB1;
            if (i + 2 < ntw) { const bf16_t* kp_ = kbase + (size_t)(16 * (w + 8 * (i + 2))) * PP; kB0 = *(const bf16x8*)kp_; kB1 = *(const bf16x8*)(kp_ + 32); }
            f32x4 s = (f32x4){0.f, 0.f, 0.f, 0.f};
            f32x4 ah[8];
#pragma unroll
            for (int hd = 0; hd < 8; ++hd) { ah[hd] = (f32x4){0.f, 0.f, 0.f, 0.f}; ah[hd] = MFMA16(k0, qf[hd][0], ah[hd]); ah[hd] = MFMA16(k1, qf[hd][1], ah[hd]); }
            asm volatile("s_nop 15" : "+v"(ah[0]), "+v"(ah[1]), "+v"(ah[2]), "+v"(ah[3]), "+v"(ah[4]), "+v"(ah[5]), "+v"(ah[6]), "+v"(ah[7]));
#pragma unroll
            for (int hd = 0; hd < 8; ++hd) {
#pragma unroll
                for (int r = 0; r < 4; ++r) { float rl; asm("v_max_f32_e32 %0, 0, %1" : "=v"(rl) : "v"(ah[hd][r])); s[r] = __builtin_fmaf(wq[hd], rl, s[r]); }
            }
#pragma unroll
            for (int r = 0; r < 4; ++r) { s[r] += 0.0f; vmin = fminf(vmin, s[r]); vmax = fmaxf(vmax, s[r]); sm1 += s[r]; sm2 = __builtin_fmaf(s[r], s[r], sm2); }
            sc[i] = s;
        } else sc[i] = (f32x4){-INFINITY, -INFINITY, -INFINITY, -INFINITY};
    }
    vmin = fminf(vmin, __shfl_xor(vmin, 16)); vmin = fminf(vmin, __shfl_xor(vmin, 32));
    vmax = fmaxf(vmax, __shfl_xor(vmax, 16)); vmax = fmaxf(vmax, __shfl_xor(vmax, 32));
    sm1 += __shfl_xor(sm1, 16); sm1 += __shfl_xor(sm1, 32); sm2 += __shfl_xor(sm2, 16); sm2 += __shfl_xor(sm2, 32);
    LAS float* msum = (LAS float*)(lds + IDXM + 8192 + 3072 + 2048 + 64 + 256);
    if (g == 0) { redf[q * 8 + w] = vmin; redf[128 + q * 8 + w] = vmax; msum[q * 8 + w] = sm1; msum[128 + q * 8 + w] = sm2; }
    __syncthreads();
    float lo, hiT;
    { const f32x4 a = *(const LAS f32x4*)(redf + q * 8), bb = *(const LAS f32x4*)(redf + q * 8 + 4); lo = fminf(fminf(fminf(a[0], a[1]), fminf(a[2], a[3])), fminf(fminf(bb[0], bb[1]), fminf(bb[2], bb[3])));
      const f32x4 c2 = *(const LAS f32x4*)(redf + 128 + q * 8), d2 = *(const LAS f32x4*)(redf + 128 + q * 8 + 4); hiT = fmaxf(fmaxf(fmaxf(c2[0], c2[1]), fmaxf(c2[2], c2[3])), fmaxf(fmaxf(d2[0], d2[1]), fmaxf(d2[2], d2[3]))); }
    float g0, gslope;
    { const f32x4 a = *(const LAS f32x4*)(msum + q * 8), bb = *(const LAS f32x4*)(msum + q * 8 + 4), c2 = *(const LAS f32x4*)(msum + 128 + q * 8), d2 = *(const LAS f32x4*)(msum + 128 + q * 8 + 4);
      const float S1 = ((a[0] + a[1]) + (a[2] + a[3])) + ((bb[0] + bb[1]) + (bb[2] + bb[3])), S2 = ((c2[0] + c2[1]) + (c2[2] + c2[3])) + ((d2[0] + d2[1]) + (d2[2] + d2[3]));
      const float nf = (float)(16 * NT), mu = S1 / nf, sd = sqrtf(fmaxf(S2 / nf - mu * mu, 0.f)), p = (float)IDX_TOPK / nf;
      const float z = 4.91f * (__builtin_amdgcn_exp2f(0.14f * __builtin_amdgcn_logf(1.0f - p)) - __builtin_amdgcn_exp2f(0.14f * __builtin_amdgcn_logf(p)));
      g0 = mu + z * sd; gslope = nf * __builtin_amdgcn_exp2f(-0.7213475f * z * z) * 0.3989423f / sd; }
    float pmid = 0.f, pstep = 0.f; unsigned pcnt = 0u; bool lop = false, hip = false;
    hiT = ord2f(f2ord(hiT) + 1u);
    bool done = false; float tge = INFINITY, veq = 0.f; int need = 0; unsigned chi = 0, clo = 16u * (unsigned)NT;
    for (int it = 0; it < 80; ++it) {
        float mid;
        if (it < 24) mid = 0.5f * (lo + hiT);
        else { const unsigned ul = f2ord(lo), uh = f2ord(hiT); mid = ord2f(ul + ((uh - ul) >> 1)); }
        if (!(lop && hip)) {
            const float gm = (it == 0) ? g0 : (it == 1) ? pmid + 2.0f * ((float)pcnt - (float)IDX_TOPK + ((pcnt > (unsigned)IDX_TOPK) ? 6.f : -6.f)) / gslope : pmid + 2.0f * pstep;
            if (gm > lo && gm < hiT) mid = gm; }
        pstep = mid - pmid;
        unsigned cnt = 0;
#pragma unroll
        for (int g4 = 0; g4 < 4; ++g4) {
            if (4 * g4 < ntw) { cnt4(cnt, sc[4 * g4], mid); cnt4(cnt, sc[4 * g4 + 1], mid); cnt4(cnt, sc[4 * g4 + 2], mid); cnt4(cnt, sc[4 * g4 + 3], mid); }
        }
        LAS unsigned char* cb = (LAS unsigned char*)cbuf + (it & 1) * 512;
        cb[q * 32 + w * 4 + g] = (unsigned char)cnt;
        __syncthreads();
        { const u32x4 a = *(const LAS u32x4*)(cb + q * 32), bb = *(const LAS u32x4*)(cb + q * 32 + 16);
          unsigned s_ = 0u;
          s_ = __builtin_amdgcn_sad_u8(a[0], 0u, s_); s_ = __builtin_amdgcn_sad_u8(a[1], 0u, s_); s_ = __builtin_amdgcn_sad_u8(a[2], 0u, s_); s_ = __builtin_amdgcn_sad_u8(a[3], 0u, s_);
          s_ = __builtin_amdgcn_sad_u8(bb[0], 0u, s_); s_ = __builtin_amdgcn_sad_u8(bb[1], 0u, s_); s_ = __builtin_amdgcn_sad_u8(bb[2], 0u, s_); s_ = __builtin_amdgcn_sad_u8(bb[3], 0u, s_);
          cnt = s_; }
        pmid = mid; pcnt = cnt;
        if (!done) {
            if (cnt == (unsigned)IDX_TOPK) { tge = mid; need = 0; done = true; }
            else if (cnt > (unsigned)IDX_TOPK) { lo = mid; clo = cnt; lop = true; }
            else { hiT = mid; chi = cnt; hip = true; }
            if (!done) {
                bool coll;
                if (it + 1 < 24) { const float m2 = 0.5f * (lo + hiT); coll = !(m2 > lo && m2 < hiT); }
                else coll = (f2ord(hiT) - f2ord(lo)) <= 1u;
                if (coll) { tge = hiT; veq = lo; need = IDX_TOPK - (int)chi; done = true; }
            }
        }
        if (__all(done || (clo - chi) <= 32u)) break;
    }
    if (!__all(done)) {
        LAS float* cand = (LAS float*)(lds + IDXM + 8192 + 3072);
        LAS float* cres = (LAS float*)(lds + IDXM + 8192 + 3072 + 2048 + 64);
        if (!done) {
#pragma unroll
            for (int g4 = 0; g4 < 4; ++g4) {
                if (4 * g4 < ntw) {
#pragma unroll
                    for (int i = 4 * g4; i < 4 * g4 + 4; ++i)
#pragma unroll
                        for (int r = 0; r < 4; ++r) { const float x = sc[i][r];
                            if (x >= lo && x < hiT) { const unsigned idx = __hip_atomic_fetch_add(ccnt + q, 1u, __ATOMIC_RELAXED, __HIP_MEMORY_SCOPE_WORKGROUP); if (idx < 32u) cand[q * 32 + idx] = x; } }
                }
            }
        }
        __syncthreads();
        const unsigned rnk = (unsigned)IDX_TOPK - chi;
        if (!done) {
            const unsigned k = ccnt[q]; const unsigned j = (unsigned)(w * 4 + g);
            if (j < k) {
                const float xj = cand[q * 32 + j]; unsigned cgt = 0, ceq = 0;
#pragma unroll
                for (int i4 = 0; i4 < 8; ++i4) { const f32x4 c4 = *(const LAS f32x4*)(cand + q * 32 + 4 * i4);
#pragma unroll
                    for (int e = 0; e < 4; ++e) { const bool in = (unsigned)(4 * i4 + e) < k; cgt += (in && c4[e] > xj) ? 1u : 0u; ceq += (in && c4[e] == xj) ? 1u : 0u; } }
                if (cgt < rnk && rnk <= cgt + ceq) { cres[q * 4] = xj; cres[q * 4 + 1] = __uint_as_float(cgt); cres[q * 4 + 2] = __uint_as_float(ceq); }
            }
        }
        __syncthreads();
        if (!done) {
            const float T = cres[q * 4]; const unsigned cgt = __float_as_uint(cres[q * 4 + 1]), ceq = __float_as_uint(cres[q * 4 + 2]);
            if (cgt + ceq == rnk) { tge = T; need = 0; }
            else { tge = ord2f(f2ord(T) + 1u); veq = T; need = (int)(rnk - cgt); }
            done = true;
        }
    }
#pragma unroll
    for (int i = 0; i < 16; ++i) {
        const int t = w + 8 * i;
        unsigned ge = 0, eq = 0;
#pragma unroll
        for (int r = 0; r < 4; ++r) { ge |= (sc[i][r] >= tge) ? (1u << r) : 0u; eq |= (need > 0 && sc[i][r] == veq) ? (1u << r) : 0u; }
        if (t < NT) { const int sh = 16 * (t & 1) + 4 * g;
            if (ge) __hip_atomic_fetch_or((LAS unsigned*)lmask + q * 64 + (t >> 1), ge << sh, __ATOMIC_RELAXED, __HIP_MEMORY_SCOPE_WORKGROUP);
            if (eq) __hip_atomic_fetch_or((LAS unsigned*)leq + q * 64 + (t >> 1), eq << sh, __ATOMIC_RELAXED, __HIP_MEMORY_SCOPE_WORKGROUP); }
    }
    if (w == 0 && g == 0) needs[q] = need;
    __syncthreads();
    if (tid < 16) {
        int nd = needs[tid];
        if (nd > 0) {
            LAS unsigned* lm = (LAS unsigned*)lmask + tid * 64; const LAS unsigned* le = (const LAS unsigned*)leq + tid * 64;
            for (int wd = 0; wd < 64 && nd > 0; ++wd) {
                unsigned e = le[wd]; unsigned add = 0;
                while (e != 0u && nd > 0) { const unsigned lowbit = e & (0u - e); add |= lowbit; e ^= lowbit; --nd; }
                if (add) lm[wd] |= add;
            }
        }
    }
    __syncthreads();
    for (int i = tid; i < 16 * 64; i += 512) { const int qq = i >> 6, wd = i & 63; __hip_atomic_store(MASK + (size_t)(row0 + qq) * 64 + wd, ((const LAS unsigned*)lmask)[qq * 64 + wd], __ATOMIC_RELAXED, __HIP_MEMORY_SCOPE_AGENT); }
    asm volatile("s_waitcnt vmcnt(0)" ::: "memory");
    __syncthreads();
    if (tid == 0) (void)__hip_atomic_fetch_add(rdy, 1u, __ATOMIC_RELAXED, __HIP_MEMORY_SCOPE_AGENT);
}

template <int KIND>
DI void tr_item(const float* __restrict__ W, const float* __restrict__ W2, const int ldw, const int Ksrc, const float* __restrict__ gk, bf16_t* __restrict__ WT, const int Kout,
                LAS float* scr, const int item, const int nblk, const int lane) {
    const int kb = item / nblk, nb = item % nblk, k0 = 64 * kb, n0 = 32 * nb;
    const int n = n0 + (lane & 31);
    int sc; const float* Wm = W;
    if (KIND == 0) sc = n;
    else if (KIND == 1) sc = win_src_col(n);
    else if (KIND == 2) sc = wuq_src_col(n);
    else { const int pn = n >> 8, r = n & 255; Wm = (r < 128) ? W : W2; sc = 128 * pn + (r & 127); }
#pragma unroll 8
    for (int i = 0; i < 32; ++i) { const int kk = 2 * i + (lane >> 5), k = k0 + kk;
        float v = 0.f;
        if (sc >= 0 && k < Ksrc) { v = Wm[(size_t)k * ldw + sc]; if (gk) v *= gk[k]; }
        scr[kk * 33 + (lane & 31)] = v; }
    asm volatile("s_waitcnt lgkmcnt(0)" ::: "memory");
    const int c = lane & 7;
#pragma unroll
    for (int j = 0; j < 4; ++j) { const int nn = (lane >> 3) + 8 * j; const LAS float* s = scr + (8 * c) * 33 + nn;
        u32x4 o; o.x = pk2(s[0 * 33], s[1 * 33]); o.y = pk2(s[2 * 33], s[3 * 33]); o.z = pk2(s[4 * 33], s[5 * 33]); o.w = pk2(s[6 * 33], s[7 * 33]);
        *(u32x4*)(WT + (size_t)(n0 + nn) * Kout + k0 + 8 * c) = o; }
    asm volatile("s_waitcnt lgkmcnt(0)" ::: "memory");
}
template <int KIND>
DI void tr_matrix(const float* W, const float* W2, int ldw, int Ksrc, const float* gk, bf16_t* WT, int Kout, int Nout, LAS float* scr, int gw, int NGW, int lane) {
    const int nblk = Nout / 32, items = (Kout / 64) * nblk;
    for (int it = gw; it < items; it += NGW) tr_item<KIND>(W, W2, ldw, Ksrc, gk, WT, Kout, scr, it, nblk, lane);
}

template <int KIND>
DI void trv_load(const float* __restrict__ W, const float* __restrict__ W2, const int ldw, const int Ksrc, const float* __restrict__ gk, const int item, const int nblk, const int lane, f32x4 (&v)[8]) {
    const int kb = item / nblk, nb = item % nblk, k0 = 32 * kb, n = 64 * nb + 4 * (lane & 15);
    const float* Wm = W; int sc = n;
    if (KIND == 1) sc = win_src_col(n);
    if (KIND == 2) sc = wuq_src_col(n);
    if (KIND == 4) { const int pn = n >> 8, r = n & 255; Wm = (r < 128) ? W : W2; sc = 128 * pn + (r & 127); }
#pragma unroll
    for (int i = 0; i < 8; ++i) { const int k = k0 + 4 * i + (lane >> 4);
        v[i] = (f32x4){0.f, 0.f, 0.f, 0.f};
        if (k < Ksrc && sc >= 0) { const float* p_ = Wm + (size_t)k * ldw + sc;
            if (KIND == 1 || KIND == 2) v[i] = (f32x4){p_[0], p_[1], p_[2], p_[3]}; else v[i] = __builtin_nontemporal_load((const f32x4*)p_);
            if (gk) v[i] = v[i] * gk[k]; } }
}
DI void trv_store(bf16_t* __restrict__ WT, const int Kout, LAS float* scr, const int item, const int nblk, const int lane, const f32x4 (&v)[8]) {
    const int kb = item / nblk, nb = item % nblk, k0 = 32 * kb, n0 = 64 * nb;
#pragma unroll
    for (int i = 0; i < 8; ++i) { LAS float* d = scr + (4 * i + (lane >> 4)) * 65 + 4 * (lane & 15); d[0] = v[i][0]; d[1] = v[i][1]; d[2] = v[i][2]; d[3] = v[i][3]; }
    asm volatile("s_waitcnt lgkmcnt(0)" ::: "memory");
    const int c = lane & 3;
#pragma unroll
    for (int j = 0; j < 4; ++j) { const int nn = (lane >> 2) + 16 * j; const LAS float* s = scr + (8 * c) * 65 + nn;
        u32x4 o; o.x = pk2(s[0 * 65], s[1 * 65]); o.y = pk2(s[2 * 65], s[3 * 65]); o.z = pk2(s[4 * 65], s[5 * 65]); o.w = pk2(s[6 * 65], s[7 * 65]);
        *(u32x4*)(WT + (size_t)(n0 + nn) * Kout + k0 + 8 * c) = o; }
    asm volatile("s_waitcnt lgkmcnt(0)" ::: "memory");
}
template <int KIND>
DI void trv_matrix(const float* W, const float* W2, int ldw, int Ksrc, const float* gk, bf16_t* WT, int Kout, int Nout, LAS float* scr, int gw, int NGW, int lane) {
    const int nblk = Nout / 64, items = (Kout / 32) * nblk;
    for (int it = gw; it < items; it += 2 * NGW) {
        f32x4 va[8], vb[8]; const int it2 = it + NGW;
        trv_load<KIND>(W, W2, ldw, Ksrc, gk, it, nblk, lane, va);
        if (it2 < items) trv_load<KIND>(W, W2, ldw, Ksrc, gk, it2, nblk, lane, vb);
        trv_store(WT, Kout, scr, it, nblk, lane, va);
        if (it2 < items) trv_store(WT, Kout, scr, it2, nblk, lane, vb);
    }
}

DI unsigned pk4_i8(float a, float b, float c, float d) { const int ia = (int)__builtin_rintf(a), ib = (int)__builtin_rintf(b), ic = (int)__builtin_rintf(c), id = (int)__builtin_rintf(d);
    return ((unsigned)ia & 0xffu) | (((unsigned)ib & 0xffu) << 8) | (((unsigned)ic & 0xffu) << 16) | ((unsigned)id << 24); }
DI void q8_strip(const float* __restrict__ Wg, const float* __restrict__ Wu, const float* __restrict__ gk, unsigned char* __restrict__ W8, float* __restrict__ sb, const int strip, LAS float* scr, const int lane) {
    const int n0 = 32 * strip, pn = n0 >> 8, r = n0 & 255;
    const float* Wm = (r < 128) ? Wg : Wu; const int c0 = 128 * pn + (r & 127) + 4 * (lane & 7); const int kr = lane >> 3;
    f32x4 mx = (f32x4){0.f, 0.f, 0.f, 0.f};
#pragma unroll 16
    for (int it = 0; it < 128; ++it) { const int k = 8 * it + kr; const f32x4 v = *(const f32x4*)(Wm + (size_t)k * DFF + c0) * gk[k];
        mx[0] = fmaxf(mx[0], fabsf(v[0])); mx[1] = fmaxf(mx[1], fabsf(v[1])); mx[2] = fmaxf(mx[2], fabsf(v[2])); mx[3] = fmaxf(mx[3], fabsf(v[3])); }
    f32x4 inv;
#pragma unroll
    for (int e = 0; e < 4; ++e) { float m = mx[e]; m = fmaxf(m, __shfl_xor(m, 8)); m = fmaxf(m, __shfl_xor(m, 16)); m = fmaxf(m, __shfl_xor(m, 32)); mx[e] = m; inv[e] = m > 0.f ? 127.0f / m : 0.f; }
    if (lane < 8) *(f32x4*)(sb + n0 + 4 * lane) = (f32x4){mx[0] > 0.f ? mx[0] * (1.0f / 127.0f) : 1.0f, mx[1] > 0.f ? mx[1] * (1.0f / 127.0f) : 1.0f, mx[2] > 0.f ? mx[2] * (1.0f / 127.0f) : 1.0f, mx[3] > 0.f ? mx[3] * (1.0f / 127.0f) : 1.0f};
#pragma unroll 1
    for (int kb = 0; kb < 16; ++kb) {
        f32x4 v[8];
#pragma unroll
        for (int i = 0; i < 8; ++i) { const int k = 64 * kb + 8 * i + kr; v[i] = *(const f32x4*)(Wm + (size_t)k * DFF + c0) * gk[k] * inv; }
#pragma unroll
        for (int i = 0; i < 8; ++i) { LAS float* d = scr + (8 * i + kr) * 33 + 4 * (lane & 7); d[0] = v[i][0]; d[1] = v[i][1]; d[2] = v[i][2]; d[3] = v[i][3]; }
        asm volatile("s_waitcnt lgkmcnt(0)" ::: "memory");
        const int nn = lane & 31, kh = lane >> 5; const LAS float* s = scr + (32 * kh) * 33 + nn;
        u32x4 o0, o1;
        o0.x = pk4_i8(s[0 * 33], s[1 * 33], s[2 * 33], s[3 * 33]);     o0.y = pk4_i8(s[4 * 33], s[5 * 33], s[6 * 33], s[7 * 33]);
        o0.z = pk4_i8(s[8 * 33], s[9 * 33], s[10 * 33], s[11 * 33]);   o0.w = pk4_i8(s[12 * 33], s[13 * 33], s[14 * 33], s[15 * 33]);
        o1.x = pk4_i8(s[16 * 33], s[17 * 33], s[18 * 33], s[19 * 33]); o1.y = pk4_i8(s[20 * 33], s[21 * 33], s[22 * 33], s[23 * 33]);
        o1.z = pk4_i8(s[24 * 33], s[25 * 33], s[26 * 33], s[27 * 33]); o1.w = pk4_i8(s[28 * 33], s[29 * 33], s[30 * 33], s[31 * 33]);
        unsigned char* dst = W8 + (size_t)(n0 + nn) * 1024 + 64 * kb + 32 * kh;
        *(u32x4*)dst = o0; *(u32x4*)(dst + 16) = o1;
        asm volatile("s_waitcnt lgkmcnt(0)" ::: "memory");
    }
}
DI void q8_strip_wg(const float* __restrict__ Wg, const float* __restrict__ Wu, const float* __restrict__ gk, unsigned char* __restrict__ W8, float* __restrict__ sb, const int strip,
                    LAS float* scr, LAS float* xmax, const int w, const int lane) {
    const int n0 = 32 * strip, pn = n0 >> 8, r = n0 & 255;
    const float* Wm = (r < 128) ? Wg : Wu; const int c0 = 128 * pn + (r & 127) + 4 * (lane & 7); const int kr = lane >> 3, kw = 128 * w;
    f32x4 v[16]; f32x4 mx = (f32x4){0.f, 0.f, 0.f, 0.f};
#pragma unroll
    for (int it = 0; it < 16; ++it) { const int k = kw + 8 * it + kr; v[it] = __builtin_nontemporal_load((const f32x4*)(Wm + (size_t)k * DFF + c0)) * gk[k]; }
#pragma unroll
    for (int it = 0; it < 16; ++it) { mx[0] = fmaxf(mx[0], fabsf(v[it][0])); mx[1] = fmaxf(mx[1], fabsf(v[it][1])); mx[2] = fmaxf(mx[2], fabsf(v[it][2])); mx[3] = fmaxf(mx[3], fabsf(v[it][3])); }
#pragma unroll
    for (int e = 0; e < 4; ++e) { float m = mx[e]; m = fmaxf(m, __shfl_xor(m, 8)); m = fmaxf(m, __shfl_xor(m, 16)); m = fmaxf(m, __shfl_xor(m, 32)); mx[e] = m; }
    if (lane < 8) *(LAS f32x4*)(xmax + w * 32 + 4 * lane) = mx;
    __syncthreads();
    f32x4 inv;
    { f32x4 m = *(const LAS f32x4*)(xmax + 4 * (lane & 7));
#pragma unroll
      for (int ww = 1; ww < 8; ++ww) { const f32x4 o = *(const LAS f32x4*)(xmax + ww * 32 + 4 * (lane & 7)); m[0] = fmaxf(m[0], o[0]); m[1] = fmaxf(m[1], o[1]); m[2] = fmaxf(m[2], o[2]); m[3] = fmaxf(m[3], o[3]); }
#pragma unroll
      for (int e = 0; e < 4; ++e) inv[e] = m[e] > 0.f ? 127.0f / m[e] : 0.f;
      if (w == 0 && lane < 8) *(f32x4*)(sb + n0 + 4 * lane) = (f32x4){m[0] > 0.f ? m[0] * (1.0f / 127.0f) : 1.0f, m[1] > 0.f ? m[1] * (1.0f / 127.0f) : 1.0f, m[2] > 0.f ? m[2] * (1.0f / 127.0f) : 1.0f, m[3] > 0.f ? m[3] * (1.0f / 127.0f) : 1.0f}; }
#pragma unroll
    for (int hf = 0; hf < 2; ++hf) {
#pragma unroll
        for (int i = 0; i < 8; ++i) { const f32x4 q = v[8 * hf + i] * inv; LAS float* d = scr + (8 * i + kr) * 33 + 4 * (lane & 7); d[0] = q[0]; d[1] = q[1]; d[2] = q[2]; d[3] = q[3]; }
        asm volatile("s_waitcnt lgkmcnt(0)" ::: "memory");
        const int nn = lane & 31, kh = lane >> 5; const LAS float* s = scr + (32 * kh) * 33 + nn;
        u32x4 o0, o1;
        o0.x = pk4_i8(s[0 * 33], s[1 * 33], s[2 * 33], s[3 * 33]);     o0.y = pk4_i8(s[4 * 33], s[5 * 33], s[6 * 33], s[7 * 33]);
        o0.z = pk4_i8(s[8 * 33], s[9 * 33], s[10 * 33], s[11 * 33]);   o0.w = pk4_i8(s[12 * 33], s[13 * 33], s[14 * 33], s[15 * 33]);
        o1.x = pk4_i8(s[16 * 33], s[17 * 33], s[18 * 33], s[19 * 33]); o1.y = pk4_i8(s[20 * 33], s[21 * 33], s[22 * 33], s[23 * 33]);
        o1.z = pk4_i8(s[24 * 33], s[25 * 33], s[26 * 33], s[27 * 33]); o1.w = pk4_i8(s[28 * 33], s[29 * 33], s[30 * 33], s[31 * 33]);
        unsigned char* dst = W8 + (size_t)(n0 + nn) * 1024 + kw + 64 * hf + 32 * kh;
        *(u32x4*)dst = o0; *(u32x4*)(dst + 16) = o1;
        asm volatile("s_waitcnt lgkmcnt(0)" ::: "memory");
    }
    __syncthreads();
}
DI void trv8_store(unsigned char* __restrict__ WT, const int Kout, LAS float* scr, const int item, const int nblk, const int lane, const f32x4 (&v)[8]) {
    const int kb = item / nblk, nb = item % nblk, k0 = 32 * kb, n0 = 64 * nb;
#pragma unroll
    for (int i = 0; i < 8; ++i) { LAS float* d = scr + (4 * i + (lane >> 4)) * 65 + 4 * (lane & 15); d[0] = v[i][0]; d[1] = v[i][1]; d[2] = v[i][2]; d[3] = v[i][3]; }
    asm volatile("s_waitcnt lgkmcnt(0)" ::: "memory");
    const int c = lane & 3;
#pragma unroll
    for (int j = 0; j < 4; ++j) { const int nn = (lane >> 2) + 16 * j; const LAS float* s = scr + (8 * c) * 65 + nn;
        u32x2 o; o.x = pk4_fp8(WD_SCALE * s[0 * 65], WD_SCALE * s[1 * 65], WD_SCALE * s[2 * 65], WD_SCALE * s[3 * 65]); o.y = pk4_fp8(WD_SCALE * s[4 * 65], WD_SCALE * s[5 * 65], WD_SCALE * s[6 * 65], WD_SCALE * s[7 * 65]);
        *(u32x2*)(WT + (size_t)(n0 + nn) * Kout + k0 + 8 * c) = o; }
    asm volatile("s_waitcnt lgkmcnt(0)" ::: "memory");
}
DI void trv8_matrix(const float* W, int ldw, int Ksrc, unsigned char* WT, int Kout, int Nout, LAS float* scr, int gw, int NGW, int lane) {
    const int nblk = Nout / 64, items = (Kout / 32) * nblk;
    for (int it = gw; it < items; it += 2 * NGW) {
        f32x4 va[8], vb[8]; const int it2 = it + NGW;
        trv_load<0>(W, nullptr, ldw, Ksrc, nullptr, it, nblk, lane, va);
        if (it2 < items) trv_load<0>(W, nullptr, ldw, Ksrc, nullptr, it2, nblk, lane, vb);
        trv8_store(WT, Kout, scr, it, nblk, lane, va);
        if (it2 < items) trv8_store(WT, Kout, scr, it2, nblk, lane, vb);
    }
}
DI void quant_regs(const f32x4 (&v)[4], unsigned char* __restrict__ q8row, float* __restrict__ ra, const int lane, float& rstd) {
    float s = 0.f, mx = 0.f;
#pragma unroll
    for (int j = 0; j < 4; ++j) { s += dot4(v[j]); mx = fmaxf(fmaxf(mx, fmaxf(fabsf(v[j][0]), fabsf(v[j][1]))), fmaxf(fabsf(v[j][2]), fabsf(v[j][3]))); }
    s = wave_sum(s);
#pragma unroll
    for (int o = 1; o < 64; o <<= 1) mx = fmaxf(mx, __shfl_xor(mx, o));
    rstd = 1.0f / sqrtf(s * (1.0f / 1024.0f) + EPS);
    const float inv = mx > 0.f ? 127.0f / mx : 0.f;
    unsigned* q = (unsigned*)q8row + lane;
#pragma unroll
    for (int j = 0; j < 4; ++j) q[64 * j] = pk4_i8(v[j][0] * inv, v[j][1] * inv, v[j][2] * inv, v[j][3] * inv);
    if (lane == 0) *ra = rstd * (mx > 0.f ? mx * (1.0f / 127.0f) : 1.0f);
}
DI void load_row(const float* __restrict__ hrow, const int lane, f32x4 (&v)[4]) { const f32x4* hr = (const f32x4*)hrow + lane;
#pragma unroll
    for (int j = 0; j < 4; ++j) v[j] = __builtin_nontemporal_load(hr + 64 * j); }

DI void load_row_bf(const bf16_t* __restrict__ hrow, const int lane, f32x4 (&v)[4]) { const u32x2* hr = (const u32x2*)hrow + lane;
#pragma unroll
    for (int j = 0; j < 4; ++j) { const u32x2 y = hr[64 * j]; v[j][0] = __uint_as_float(y.x << 16); v[j][1] = __uint_as_float(y.x & 0xffff0000u); v[j][2] = __uint_as_float(y.y << 16); v[j][3] = __uint_as_float(y.y & 0xffff0000u); } }

struct Args { const float* in[23]; float* out; unsigned char* ws; double invfreq[NFREQ]; int ph_lo, ph_hi; };

DI void moe_tables(const unsigned* ecnt, LAS int* tbase, LAS int* tile_e, int tid) {
    if (tid == 0) { int acc = 0; for (int l = 0; l < 16; ++l) { tbase[l] = acc; const int n = (int)__hip_atomic_load(ecnt + 64 * l, RLX_AGENT); acc += (n + 255) >> 8; } tbase[16] = acc; }
    __syncthreads();
    for (int t = tid; t < MAXSLOT_TILES; t += 512) { int l = 0; for (int k = 1; k < 16; ++k) l = (t >= tbase[k]) ? k : l; tile_e[t] = l; }
    __syncthreads();
}

#define KARG ((const __attribute__((address_space(4))) Args*)__builtin_amdgcn_kernarg_segment_ptr())
DI const __attribute__((address_space(4))) Args* karg_l() { auto p = KARG; asm volatile("" : "+s"(p)); return p; }
#define INP(i) (karg_l()->in[i])
#define OUTP() (karg_l()->out)
#define WSP() (karg_l()->ws)
#define WSF(off) ((float*)(WSP() + (off)))
#define WSI(off) ((int*)(WSP() + (off)))
#define WSB(off) ((bf16_t*)(WSP() + (off)))
#define HBP() ((bf16_t*)OUTP())
__global__ void __launch_bounds__(512, 2) fwd_kernel(Args args) {
    extern __shared__ __attribute__((aligned(16))) unsigned char lds_raw[];
    LAS unsigned char* lds = (LAS unsigned char*)lds_raw;
    volatile LAS unsigned* MISC = (volatile LAS unsigned*)(lds + MISC_OFF);
    LAS int* tbase = (LAS int*)(lds + LDSX_OFF);
    LAS int* tile_e = (LAS int*)(lds + LDSX_OFF + 128);
    const int tid = threadIdx.x, lane = tid & 63; const int wave = __builtin_amdgcn_readfirstlane(tid >> 6);
    const int G = gridDim.x; const int vcu = (G % 8 == 0) ? ((int)blockIdx.x % 8) * (G / 8) + (int)blockIdx.x / 8 : (int)blockIdx.x;
    const int gw = vcu * 8 + wave, NGW = G * 8;
    unsigned* ctl = (unsigned*)(WSP() + WS_CTL);
    for (int u = tid; u < (LDS_BYTES - RING_BYTES) / 4; u += 512) ((LAS unsigned*)(lds + RING_BYTES))[u] = 0u;
    __syncthreads();
    XcdBarrier bar = xcd_barrier_post(ctl + CW_BAR, MISC + 8);
    const int lo = KARG->ph_lo, hi = KARG->ph_hi;
    int ph = 0;
#ifndef PHMASK
#define PHMASK 0xffffffffu
#endif
#define PHON(k) (((PHMASK) >> (k)) & 1u)
#ifndef DUPMASK
#define DUPMASK 0u
#endif
#define DUPN(k) ((((DUPMASK) >> (k)) & 1u) ? 2 : 1)
#define DUP_BEGIN(k) for (int rep = DUPN(k) - 1; rep >= 0; --rep) { const float ascale = rep ? 0.f : 1.f; (void)ascale;
#define DUP_END() if (rep) xcd_barrier(bar); }
#define IN_PH() (lo <= ph && ph < hi)
#define SEAM() do { if (lo <= ph && ph + 1 < hi) xcd_barrier(bar); ++ph; } while (0)
    if (PHON(0) && IN_PH()) { DUP_BEGIN(0)
        LAS float* scr = (LAS float*)(lds + wave * 16384);
        for (int l = 0; l < 2; ++l) {
            unsigned char* wl = WSP() + WS_WSMALL + (size_t)l * WO_L1;
            trv_matrix<1>(INP(3) + (size_t)l * 1024 * NIN, nullptr, NIN, 1024, INP(2) + l * 1024, (bf16_t*)(wl + WO_IN0), 1024, NINP, scr, gw, NGW, lane);
            trv_matrix<2>(INP(5) + (size_t)l * 256 * 768, nullptr, 768, 256, INP(4) + l * 256, (bf16_t*)(wl + WO_UQ0), 256, 768, scr, gw, NGW, lane);
            trv_matrix<0>(INP(7) + (size_t)l * 128 * 1024, nullptr, 1024, 128, INP(6) + l * 128, (bf16_t*)(wl + WO_UKV0), 256, 1024, scr, gw, NGW, lane);
            trv_matrix<0>(INP(13) + (size_t)l * 1024 * 1024, nullptr, 1024, 1024, nullptr, (bf16_t*)(wl + WO_OUT0), 1024, 1024, scr, gw, NGW, lane);
        }
        for (int s = vcu; s < 2 * DFF / 32; s += G) q8_strip_wg(INP(15), INP(16), INP(14), WSP() + WS_WSMALL + WO_GU, WSF(WS_SBD), s, scr, (LAS float*)(lds + 8 * 16384 - 1024), wave, lane);
        trv8_matrix(INP(17), 1024, DFF, WSP() + WS_WSMALL + WO_D, DFF, 1024, scr, gw, NGW, lane);
        { f32x4 nv[4], nw[4];
          if (gw < MTOK) load_row(INP(0) + (size_t)gw * DM, lane, nv);
          if (gw + NGW < MTOK) load_row(INP(0) + (size_t)(gw + NGW) * DM, lane, nw);
        for (int m = gw; m < MTOK; m += NGW) {
            f32x4 v[4]; float s = 0.f;
#pragma unroll
            for (int j = 0; j < 4; ++j) { v[j] = nv[j]; nv[j] = nw[j]; s += dot4(v[j]); }
            if (m + 2 * NGW < MTOK) load_row(INP(0) + (size_t)(m + 2 * NGW) * DM, lane, nw);
            s = wave_sum(s);
            u32x2* o8 = (u32x2*)(HBP() + (size_t)m * DM) + lane;
#pragma unroll
            for (int j = 0; j < 4; ++j) { u32x2 o; o.x = pk2(v[j][0], v[j][1]); o.y = pk2(v[j][2], v[j][3]); o8[64 * j] = o; }
            if (lane < 16) WSF(WS_SSQA)[(size_t)m * 16 + lane] = (lane == 0) ? s : 0.f;
        } }
        for (int i = (vcu * 512 + tid); i < MTOK * NFREQ; i += G * 512) {
            const int m = i / NFREQ, f = i % NFREQ;
            const double a = (double)((const int*)INP(1))[m] * KARG->invfreq[f];
            const double kq = __builtin_rint(a * 0.15915494309189535);
            const float r = (float)(a - kq * 6.283185307179586);
            WSF(WS_CS)[(size_t)m * CSW + f] = cosf(r); WSF(WS_CS)[(size_t)m * CSW + NFREQ + f] = sinf(r);
        }
     DUP_END() }
    SEAM();

    for (int l = 0; l < 2; ++l) {
        const unsigned char* wl = WSP() + WS_WSMALL + (size_t)l * WO_L1;
        if (PHON(1) && IN_PH()) { DUP_BEGIN(1)
            SchedDense S; S.T.init(MTOK / 256, NINP / 256, G, (int)blockIdx.x, 0); S.lda2 = DM * 2; S.arow0 = 0; S.A = (const char*)HBP(); S.Bt = (const char*)(wl + WO_IN0); S.btile = (size_t)256 * 1024 * 2;
            EpiIn E{WSB(WS_P), WSF(WS_SSQA), WSF(WS_CS), WSF(WS_SSQCQ), WSF(WS_SSQCKV)};
            pg8::gemm_phase<0, EpiIn, SchedDense, true>(lds, 2048, S, E);
         DUP_END() }
        SEAM();
        if (PHON(2) && IN_PH()) { DUP_BEGIN(2)
#ifndef NO_G2
            { SchedDense S; S.T.init(MTOK / 256, 3, G, (int)blockIdx.x, 0); S.lda2 = PP * 2; S.arow0 = 0; S.A = (const char*)(WSB(WS_P) + TCQ); S.Bt = (const char*)(wl + WO_UQ0); S.btile = (size_t)256 * 256 * 2;
              EpiLat<true> E{WSB(WS_QC), 768, WSF(WS_SSQCQ), 1.0f / 256.0f, WSF(WS_CS)};
              pg8::gemm_phase<0, EpiLat<true>, SchedDense, true>(lds, 512, S, E); }
#endif
         DUP_END() }
        if (PHON(13) && IN_PH()) { DUP_BEGIN(13)
#ifndef NO_G3
            { SchedDense S; S.T.init(MTOK / 256, 4, G, (int)blockIdx.x, 0); S.lda2 = PP * 2; S.arow0 = 0; S.A = (const char*)(WSB(WS_P) + TCKV); S.Bt = (const char*)(wl + WO_UKV0); S.btile = (size_t)256 * 256 * 2;
              EpiLat<false> E{WSB(WS_KV), 1024, WSF(WS_SSQCKV), 1.0f / 128.0f, WSF(WS_CS)};
              pg8::gemm_phase<0, EpiLat<false>, SchedDense, true>(lds, 512, S, E); }
#endif
         DUP_END() }
        SEAM();
        if (PHON(3) && IN_PH()) { DUP_BEGIN(3)
            int tid = threadIdx.x; asm volatile("" : "+v"(tid)); const int lane = tid & 63;
            const float lam_init = (l == 0) ? 0.2f : (0.8f - 0.6f * 0.7408182206817179f);
            float lam;
            { const float* q1 = INP(8) + l * 32; const float* k1 = INP(9) + l * 32; const float* q2 = INP(10) + l * 32; const float* k2 = INP(11) + l * 32;
              float a = (lane < 32) ? q1[lane] * k1[lane] : 0.f, bq = (lane < 32) ? q2[lane] * k2[lane] : 0.f; a = wave_sum(a); bq = wave_sum(bq); lam = expf(a) - expf(bq) + lam_init; }
            unsigned* qc = ctl + CW_QUEUE + 64 * (2 * l + 4 * rep);
            unsigned* rdy = ctl + CW_MASKRDY + 16 * 512 * l;
            for (;;) {
                if (tid == 0) MISC[0] = __hip_atomic_fetch_add(qc, 1u, RLX_AGENT);
                __syncthreads();
                const int i = (int)MISC[0];
                __syncthreads();
                if (i >= 1024 + 448 + 256 + 512) break;
                if (i < 1024) { const int qb = 7 - i / 128, rem = i % 128; attn_unit<0>(lds, WSB(WS_P), WSB(WS_QC), WSB(WS_KV), ((unsigned*)(WSP() + WS_MASK)), WSB(WS_RA), rem / 8, rem % 8, qb, nullptr, 0.f, 0.f); }
                else if (i < 1024 + 448) {
#pragma unroll 1
                    for (int u2 = 0; u2 < 4; ++u2) { const int j = 4 * (i - 1024) + u2, bb = j % 16, g16 = 127 - j / 16; idx_unit(lds, WSB(WS_P), ((unsigned*)(WSP() + WS_MASK)), bb, g16, rdy + 16 * (32 * bb + (g16 >> 2))); } }
                else if (i < 1024 + 448 + 256) {
#pragma unroll 1
                    for (int u2 = 0; u2 < 4; ++u2) { const int k = 4 * (i - (1024 + 448)) + u2, qb = 15 - k / 64, rem = k % 64; attn_unit<1>(lds, WSB(WS_P), WSB(WS_QC), WSB(WS_KV), ((unsigned*)(WSP() + WS_MASK)), WSB(WS_RA), rem / 4, rem % 4, qb, INP(12) + l * 64, lam, 1.0f - lam_init); } }
                else { const int j = i - (1024 + 448 + 256), bb = j % 16, qb = 31 - j / 16;
                    if (qb >= 4) {
                        if (tid == 0) { unsigned* f = rdy + 16 * (32 * bb + qb); unsigned sp = 0u;
                            while (__hip_atomic_load(f, __ATOMIC_RELAXED, __HIP_MEMORY_SCOPE_AGENT) < 4u) { __builtin_amdgcn_s_sleep(2); if (++sp > (1u << 26)) break; }
                            __builtin_amdgcn_fence(__ATOMIC_ACQUIRE, "agent"); asm volatile("s_waitcnt vmcnt(0)" ::: "memory"); }
                        __syncthreads();
                    }
                    attn_unit<2>(lds, WSB(WS_P), WSB(WS_QC), WSB(WS_KV), ((unsigned*)(WSP() + WS_MASK)), WSB(WS_RA), bb, 0, qb, nullptr, 0.f, 0.f); }
            }
         DUP_END() }
        SEAM();
        if (PHON(5) && IN_PH()) { DUP_BEGIN(5)
            SchedDense S; S.T.init(MTOK / 256, 4, G, (int)blockIdx.x, 0); S.lda2 = DM * 2; S.arow0 = 0; S.A = (const char*)WSB(WS_RA); S.Bt = (const char*)(wl + WO_OUT0); S.btile = (size_t)256 * 1024 * 2;
            EpiResB E{HBP(), nullptr, ascale};
            pg8::gemm_phase<0, EpiResB, SchedDense, true>(lds, 2048, S, E);
         DUP_END() }
        SEAM();
        if (l == 0) {
            if (PHON(14) && IN_PH()) {
                int tid = threadIdx.x; asm volatile("" : "+v"(tid)); const int lane = tid & 63;
                for (int m = gw; m < MTOK; m += NGW) { f32x4 v[4]; float rstd; load_row_bf(HBP() + (size_t)m * DM, lane, v); quant_regs(v, WSP() + WS_HB8 + (size_t)m * DM, WSF(WS_RSTDTOK) + m, lane, rstd); }
            }
            SEAM();
            if (PHON(6) && IN_PH()) { DUP_BEGIN(6)
                SchedDense S; S.T.init(MTOK / 256, 28, G, (int)blockIdx.x, 0); S.lda2 = DM; S.arow0 = 0; S.A = (const char*)(WSP() + WS_HB8); S.Bt = (const char*)(WSP() + WS_WSMALL + WO_GU); S.btile = (size_t)256 * 1024;
                EpiGU8<false> E{WSP() + WS_ACT8, WSF(WS_RSTDTOK), WSF(WS_SBD), nullptr, tile_e};
                pg8::gemm_phase<1, EpiGU8<false>, SchedDense, true>(lds, 1024, S, E);
             DUP_END() }
            SEAM();
            if (PHON(7) && IN_PH()) { DUP_BEGIN(7)
                SchedDense S; S.T.init(MTOK / 256, 4, G, (int)blockIdx.x, 0); S.lda2 = DFF; S.arow0 = 0; S.A = (const char*)(WSP() + WS_ACT8); S.Bt = (const char*)(WSP() + WS_WSMALL + WO_D); S.btile = (size_t)256 * DFF;
                EpiResB E{HBP(), WSF(WS_SSQA), ascale * (1.0f / (ACT_SCALE * WD_SCALE))};
                pg8::gemm_phase<2, EpiResB, SchedDense, true>(lds, DFF, S, E);
             DUP_END() }
            SEAM();
        } else {
            if (PHON(8) && IN_PH()) {
                int tid = threadIdx.x; asm volatile("" : "+v"(tid)); const int lane = tid & 63;
                LAS float* scr = (LAS float*)(lds + wave * 16384);
                for (int s = vcu; s < NEXP * (2 * DFF / 32); s += G) { const int e = s / (2 * DFF / 32), ss = s % (2 * DFF / 32);
                    q8_strip_wg(INP(19) + (size_t)e * 1024 * DFF, INP(20) + (size_t)e * 1024 * DFF, INP(14) + 1024, WSP() + WS_WMOE + (size_t)e * WB_GU, WSF(WS_SBM) + (size_t)e * 2 * DFF, ss, scr, (LAS float*)(lds + 8 * 16384 - 1024), wave, lane); }
                for (int e = 0; e < NEXP; ++e) trv8_matrix(INP(21) + (size_t)e * DFF * 1024, 1024, DFF, WSP() + WS_WMOE + (size_t)NEXP * WB_GU + (size_t)e * WB_D, DFF, 1024, scr, gw, NGW, lane);
                __syncthreads();
                for (int i = vcu * 512 + tid; i < MAXSLOTS; i += G * 512) WSI(WS_ROWTOK)[i] = -1;
                LAS int* lcnt = (LAS int*)lds;
                LAS int* ltk = (LAS int*)(lds + 256);
                LAS float* lgt = (LAS float*)(lds + 256 + 2048);
                if (tid < 32) lcnt[tid] = 0;
                __syncthreads();
                if (G * 128 >= MTOK) {
                    LAS float* plog = (LAS float*)(lds + 4096) + wave * 16 * 9;
                    {
                        float gr[16][8];
                        { const float* gn = INP(14) + 1024; const float* rt = INP(18);
#pragma unroll
                          for (int j = 0; j < 4; ++j)
#pragma unroll
                              for (int i = 0; i < 4; ++i) { const int k = 256 * j + 4 * lane + i; const float gk = gn[k]; const f32x4 r0 = *(const f32x4*)(rt + k * 8), r1 = *(const f32x4*)(rt + k * 8 + 4);
#pragma unroll
                                  for (int e = 0; e < 4; ++e) { gr[4 * j + i][e] = gk * r0[e]; gr[4 * j + i][4 + e] = gk * r1[e]; } } }
                        const int m0 = vcu * 128 + wave * 16;
                        f32x4 nv[4]; load_row_bf(HBP() + (size_t)m0 * DM, lane, nv);
#pragma unroll 1
                        for (int tt = 0; tt < 16; ++tt) {
                            const int m = m0 + tt;
                            f32x4 v[4]; float rstd_m;
#pragma unroll
                            for (int j = 0; j < 4; ++j) v[j] = nv[j];
                            if (tt + 1 < 16) load_row_bf(HBP() + (size_t)(m + 1) * DM, lane, nv);
                            quant_regs(v, WSP() + WS_HB8 + (size_t)m * DM, WSF(WS_RSTDTOK) + m, lane, rstd_m);
                            float lg[8];
#pragma unroll
                            for (int e = 0; e < 8; ++e) { float a = 0.f;
#pragma unroll
                                for (int j = 0; j < 4; ++j)
#pragma unroll
                                    for (int i = 0; i < 4; ++i) a += v[j][i] * gr[4 * j + i][e];
                                lg[e] = wave_sum(a); }
                            if (lane == 0) {
#pragma unroll
                                for (int e = 0; e < 8; ++e) plog[tt * 9 + e] = lg[e];
                                plog[tt * 9 + 8] = rstd_m; }
                        }
                    }
                    asm volatile("s_waitcnt lgkmcnt(0)" ::: "memory");
                    if (lane < 16) {
                        const int tl = wave * 16 + lane, m = vcu * 128 + tl;
                        if (m < MTOK) {
                            const float rstd = plog[lane * 9 + 8];
                            float lg[8];
#pragma unroll
                            for (int e = 0; e < 8; ++e) lg[e] = plog[lane * 9 + e] * rstd;
                            int e1 = 0; float v1 = lg[0];
#pragma unroll
                            for (int e = 1; e < 8; ++e) if (lg[e] > v1) { v1 = lg[e]; e1 = e; }
                            int e2 = -1; float v2 = -INFINITY;
#pragma unroll
                            for (int e = 0; e < 8; ++e) if (e != e1 && lg[e] > v2) { v2 = lg[e]; e2 = e; }
                            const float g2 = 1.0f / (1.0f + expf(v1 - v2)), g1 = 1.0f - g2;
                            const int p1 = __hip_atomic_fetch_add(lcnt + e1, 1, __ATOMIC_RELAXED, __HIP_MEMORY_SCOPE_WORKGROUP);
                            const int p2 = __hip_atomic_fetch_add(lcnt + 8 + e2, 1, __ATOMIC_RELAXED, __HIP_MEMORY_SCOPE_WORKGROUP);
                            ltk[tl * 4 + 0] = e1; ltk[tl * 4 + 1] = p1; ltk[tl * 4 + 2] = 8 + e2; ltk[tl * 4 + 3] = p2; lgt[tl * 2] = g1; lgt[tl * 2 + 1] = g2;
                        }
                    }
                    __syncthreads();
                    if (tid < 16) lcnt[16 + tid] = (int)__hip_atomic_fetch_add((ctl + CW_ECNT) + 64 * tid, (unsigned)lcnt[tid], RLX_AGENT);
                    __syncthreads();
                    if (tid < 128) { const int m = vcu * 128 + tid;
                        if (m < MTOK) { const int l1 = ltk[tid * 4], l2 = ltk[tid * 4 + 2];
                            WSI(WS_TOKLIST)[2 * m] = l1; WSI(WS_TOKLIST)[2 * m + 1] = l2; WSI(WS_TOKPOS)[2 * m] = lcnt[16 + l1] + ltk[tid * 4 + 1]; WSI(WS_TOKPOS)[2 * m + 1] = lcnt[16 + l2] + ltk[tid * 4 + 3];
                            WSF(WS_TOKGATE)[2 * m] = lgt[tid * 2]; WSF(WS_TOKGATE)[2 * m + 1] = lgt[tid * 2 + 1]; } }
                }
                __syncthreads();
            }
            SEAM();
            if (PHON(9) && IN_PH()) {
                int tid = threadIdx.x; asm volatile("" : "+v"(tid));
                moe_tables((ctl + CW_ECNT), tbase, tile_e, tid);
                for (int i = vcu * 512 + tid; i < MTOK * 2; i += G * 512) {
                    const int slot = tbase[WSI(WS_TOKLIST)[i]] * 256 + WSI(WS_TOKPOS)[i];
                    WSI(WS_ROWTOK)[slot] = i >> 1; WSF(WS_ROWGATE)[slot] = WSF(WS_TOKGATE)[i];
                }
            }
            SEAM();
            if (lo > ph - 1) moe_tables((ctl + CW_ECNT), tbase, tile_e, tid);
            const int ntile = tbase[16];
            if (PHON(10) && IN_PH() && ntile > 0) { DUP_BEGIN(10)
                SchedMoeGU S; S.T.init(ntile, 28, G, (int)blockIdx.x, 0); S.lda2 = DM; S.A = (const char*)(WSP() + WS_HB8); S.rowtok = WSI(WS_ROWTOK); S.tile_e = tile_e; S.Bt = (const char*)(WSP() + WS_WMOE); S.btile = (size_t)256 * 1024; S.estride = WB_GU;
                EpiGU8<true> E{WSP() + WS_ACT8, WSF(WS_RSTDTOK), WSF(WS_SBM), WSI(WS_ROWTOK), tile_e};
                pg8::gemm_phase<1, EpiGU8<true>, SchedMoeGU, true>(lds, 1024, S, E);
             DUP_END() }
            SEAM();
            if (PHON(11) && IN_PH() && ntile > 0) { DUP_BEGIN(11)
                SchedMoeD S; S.T.init(ntile, 4, G, (int)blockIdx.x, 0); S.lda2 = DFF; S.arow0 = 0; S.A = (const char*)(WSP() + WS_ACT8); S.tile_e = tile_e; S.Bt = (const char*)(WSP() + WS_WMOE + (size_t)NEXP * WB_GU); S.btile = (size_t)256 * DFF; S.estride = WB_D;
                EpiDownMoe E{HBP(), WSB(WS_RA), WSI(WS_ROWTOK), WSF(WS_ROWGATE), tile_e, ascale * (1.0f / (ACT_SCALE * WD_SCALE))};
                pg8::gemm_phase<2, EpiDownMoe, SchedMoeD, true>(lds, DFF, S, E);
             DUP_END() }
            SEAM();
        }
    }
    if (PHON(12) && IN_PH()) {
        int tid = threadIdx.x; asm volatile("" : "+v"(tid)); const int lane = tid & 63;
        const float* gf = INP(22);
        u32x2 hreg[16][4];
#pragma unroll
        for (int r = 0; r < 16; ++r) { const u32x2* hr = (const u32x2*)(HBP() + (size_t)(gw + r * NGW) * DM) + lane;
#pragma unroll
            for (int j = 0; j < 4; ++j) hreg[r][j] = __builtin_nontemporal_load(hr + 64 * j); }
        xcd_barrier(bar);
        f32x4 g4[4];
#pragma unroll
        for (int j = 0; j < 4; ++j) g4[j] = *((const f32x4*)gf + 64 * j + lane);
#pragma unroll
        for (int r = 0; r < 16; ++r) {
            const int m = gw + r * NGW;
            f32x4* orow = (f32x4*)(OUTP() + (size_t)m * DM) + lane; const u32x2* yr = (const u32x2*)(WSB(WS_RA) + (size_t)m * DM) + lane; f32x4 v[4]; float s = 0.f;
#pragma unroll
            for (int j = 0; j < 4; ++j) { const u32x2 y = __builtin_nontemporal_load(yr + 64 * j);
                v[j] = bf2lo(hreg[r][j].x, hreg[r][j].y) + bf2lo(y.x, y.y);
                s += dot4(v[j]); }
            s = wave_sum(s);
            const float rstd = 1.0f / sqrtf(s * (1.0f / 1024.0f) + EPS);
#pragma unroll
            for (int j = 0; j < 4; ++j) __builtin_nontemporal_store(v[j] * rstd * g4[j], orow + 64 * j);
        }
    }
#undef IN_PH
#undef SEAM
}

extern "C" void kernel_launch(void* const* d_in, const int* in_sizes, int n_in, void* d_out, int out_size, void* d_ws, size_t ws_size, hipStream_t stream) {
    static int grid = 0;
    if (grid == 0) {
        if (n_in != 23 || out_size != MTOK * DM || ws_size < WS_END) { fprintf(stderr, "kernel_launch: unexpected shapes (n_in %d out %d ws %zu need %zu)\n", n_in, out_size, ws_size, (size_t)WS_END); grid = -1; return; }
        int dev = 0, cus = 0, per_cu = 0;
        if (hipGetDevice(&dev) != hipSuccess || hipDeviceGetAttribute(&cus, hipDeviceAttributeMultiprocessorCount, dev) != hipSuccess) { grid = -1; return; }
        if (hipFuncSetAttribute((const void*)fwd_kernel, hipFuncAttributeMaxDynamicSharedMemorySize, LDS_BYTES) != hipSuccess) { fprintf(stderr, "kernel_launch: hipFuncSetAttribute failed\n"); grid = -1; return; }
        if (hipOccupancyMaxActiveBlocksPerMultiprocessor(&per_cu, (const void*)fwd_kernel, 512, LDS_BYTES) != hipSuccess || per_cu < 1) { fprintf(stderr, "kernel_launch: occupancy query says %d\n", per_cu); (void)hipGetLastError(); grid = -1; return; }
        grid = cus;
    }
    if (grid < 0) return;
    (void)hipMemsetAsync((char*)d_ws + WS_CTL, 0, CTL_ZERO_BYTES, stream);
    Args a{};
    for (int i = 0; i < 23; ++i) a.in[i] = (const float*)d_in[i];
    a.out = (float*)d_out; a.ws = (unsigned char*)d_ws;
    for (int i = 0; i < 8; ++i) a.invfreq[i] = pow(500000.0, -((double)i * 2.0 / 16.0));
    for (int i = 0; i < 4; ++i) a.invfreq[8 + i] = pow(500000.0, -((double)i * 2.0 / 8.0));
    for (int i = 0; i < 16; ++i) a.invfreq[12 + i] = pow(500000.0, -((double)i * 2.0 / 32.0));
    a.ph_lo = 0; a.ph_hi = 1000;
    hipLaunchKernelGGL(fwd_kernel, dim3(grid), dim3(512), LDS_BYTES, stream, a);
}
```
